# Optimizing an MI355X kernel written in HIP

```python
import math
import jax, jax.numpy as jnp
from jax import lax
import numpy as np

D_MODEL = 1024
BATCH = 8
SEQ = 4096
DEPTH = 1

CHUNK = 64
Q_BLOCK = 128
ATTN_WIDTH = D_MODEL // 2
ATTN_HEADS = 4
ATTN_SUB_DIM = ATTN_WIDTH // (2 * ATTN_HEADS)
ATTN_V_DIM = 2 * ATTN_SUB_DIM
SSM_WIDTH = D_MODEL // 2
SSM_GROUP = 16
SSM_GROUPS = SSM_WIDTH // SSM_GROUP
SSM_STATE = 64
REL_BUCKETS = 32
REL_MAX_DIST = 128
EPS = 1e-6
DT_MIN = 1e-3
DT_MAX = 1e-1
IN_SIZES = [ATTN_WIDTH, ATTN_WIDTH, ATTN_HEADS * ATTN_V_DIM, ATTN_WIDTH,
            SSM_WIDTH, SSM_WIDTH, 2 * D_MODEL]
IN_COLS = sum(IN_SIZES)
IN_SPLITS = [sum(IN_SIZES[:i + 1]) for i in range(len(IN_SIZES) - 1)]

kernel_name = "hybrid_diffattn_s5_gated_merge"


def rms_norm(x, gain):
    xf = x.astype(jnp.float32)
    y = xf * lax.rsqrt(jnp.mean(xf * xf, axis=-1, keepdims=True) + EPS)
    return (y * gain.astype(jnp.float32)).astype(x.dtype)


def t5_relative_bucket(rel):
    nb = REL_BUCKETS // 2
    max_exact = nb // 2
    side = jnp.where(rel > 0, nb, 0)
    n = jnp.abs(rel)
    nf = jnp.maximum(n, 1).astype(jnp.float32)
    large = max_exact + (jnp.log(nf / max_exact) / math.log(REL_MAX_DIST / max_exact)
                         * (nb - max_exact)).astype(jnp.int32)
    large = jnp.minimum(large, nb - 1)
    return side + jnp.where(n < max_exact, n, large)


def diff_attention(q, k, v, lam, rel_table, subln_gain, lam_init):
    B, L = q.shape[0], q.shape[1]
    nb = L // Q_BLOCK
    scale = ATTN_SUB_DIM ** -0.5
    q_blocks = q.reshape(B, nb, Q_BLOCK, ATTN_HEADS, 2, ATTN_SUB_DIM).transpose(1, 0, 2, 3, 4, 5)
    k_pos = jnp.arange(L)

    def one_block(args):
        q_blk, blk = args
        q_pos = blk * Q_BLOCK + jnp.arange(Q_BLOCK)
        s = jnp.einsum('bqhsd,bkhsd->bhsqk', q_blk, k).astype(jnp.float32) * scale
        bias = rel_table[t5_relative_bucket(k_pos[None, :] - q_pos[:, None])]
        bias = jnp.transpose(bias, (2, 0, 1)).astype(jnp.float32)[None, :, None]
        allowed = (k_pos[None, :] // CHUNK) <= (q_pos[:, None] // CHUNK)
        s = jnp.where(allowed, s + bias, -jnp.inf)
        p = jax.nn.softmax(s, axis=-1)
        attn = p[:, :, 0] - lam * p[:, :, 1]
        return jnp.einsum('bhqk,bkhd->bqhd', attn.astype(v.dtype), v)

    out = lax.map(one_block, (q_blocks, jnp.arange(nb)))
    out = out.transpose(1, 0, 2, 3, 4).reshape(B, L, ATTN_HEADS, ATTN_V_DIM)
    out = rms_norm(out, subln_gain) * (1.0 - lam_init)
    return out.reshape(B, L, ATTN_HEADS * ATTN_V_DIM)


def ssm_combine(left, right):
    ar_l, ai_l, br_l, bi_l = left
    ar_r, ai_r, br_r, bi_r = right
    ar = ar_r * ar_l - ai_r * ai_l
    ai = ar_r * ai_l + ai_r * ar_l
    br = ar_r * br_l - ai_r * bi_l + br_r
    bi = ar_r * bi_l + ai_r * br_l + bi_r
    return (ar, ai, br, bi)


def s5_branch(u, A_re, A_im, log_dt, B_re, B_im, C_re, C_im, D, glu_w, glu_b):
    f32 = jnp.float32
    Bsz, L = u.shape[0], u.shape[1]
    uf = u.astype(f32).reshape(Bsz, L, SSM_GROUPS, SSM_GROUP)
    a_re = A_re.astype(f32)
    a_im = A_im.astype(f32)
    dt = jnp.exp(log_dt.astype(f32))[:, None]
    decay = jnp.exp(a_re * dt)
    lb_re = decay * jnp.cos(a_im * dt)
    lb_im = decay * jnp.sin(a_im * dt)
    nr = lb_re - 1.0
    ni = lb_im
    den = a_re * a_re + a_im * a_im
    q_re = (nr * a_re + ni * a_im) / den
    q_im = (ni * a_re - nr * a_im) / den
    b_re = B_re.astype(f32)
    b_im = B_im.astype(f32)
    bb_re = q_re[..., None] * b_re - q_im[..., None] * b_im
    bb_im = q_re[..., None] * b_im + q_im[..., None] * b_re
    bu_re = jnp.einsum('blgh,gph->blgp', uf, bb_re)
    bu_im = jnp.einsum('blgh,gph->blgp', uf, bb_im)
    shape_a = (1, L, SSM_GROUPS, SSM_STATE)
    a_el_re = jnp.broadcast_to(lb_re[None, None], shape_a)
    a_el_im = jnp.broadcast_to(lb_im[None, None], shape_a)
    _, _, x_re, x_im = lax.associative_scan(ssm_combine, (a_el_re, a_el_im, bu_re, bu_im), axis=1)
    y = (jnp.einsum('blgp,ghp->blgh', x_re, C_re.astype(f32))
         - jnp.einsum('blgp,ghp->blgh', x_im, C_im.astype(f32))
         + D.astype(f32) * uf)
    y = y.reshape(Bsz, L, SSM_WIDTH)
    g = jax.nn.gelu(y)
    y = g * jax.nn.sigmoid(g @ glu_w.astype(f32) + glu_b.astype(f32))
    return y.astype(u.dtype)


def setup_inputs(seed: int = 0) -> dict:
    key = jax.random.key(seed)
    ks = jax.random.split(key, 24)
    f32 = jnp.float32
    nrm = lambda k, shape, s: (jax.random.normal(k, shape, f32) * s)
    x = jax.random.normal(ks[0], (BATCH, SEQ, D_MODEL), f32)
    norm_gain = 1.0 + nrm(ks[1], (DEPTH, D_MODEL), 0.01)
    w_in = nrm(ks[2], (DEPTH, D_MODEL, IN_COLS), D_MODEL ** -0.5)
    merge_gate_b = nrm(ks[3], (DEPTH, 2 * D_MODEL), 0.01)
    q_norm_gain = 1.0 + nrm(ks[4], (DEPTH, ATTN_SUB_DIM), 0.01)
    k_norm_gain = 1.0 + nrm(ks[5], (DEPTH, ATTN_SUB_DIM), 0.01)
    lambda_q1 = nrm(ks[6], (DEPTH, ATTN_SUB_DIM), 0.1)
    lambda_k1 = nrm(ks[7], (DEPTH, ATTN_SUB_DIM), 0.1)
    lambda_q2 = nrm(ks[8], (DEPTH, ATTN_SUB_DIM), 0.1)
    lambda_k2 = nrm(ks[9], (DEPTH, ATTN_SUB_DIM), 0.1)
    diff_subln_gain = 1.0 + nrm(ks[10], (DEPTH, ATTN_V_DIM), 0.01)
    rel_bias_table = nrm(ks[11], (REL_BUCKETS, ATTN_HEADS), 0.5)
    n_idx = jnp.arange(SSM_STATE, dtype=f32)
    ssm_A_re = -0.5 + nrm(ks[12], (DEPTH, SSM_GROUPS, SSM_STATE), 0.01)
    ssm_A_im = math.pi * n_idx[None, None, :] + nrm(ks[13], (DEPTH, SSM_GROUPS, SSM_STATE), 0.01)
    ssm_log_dt = jax.random.uniform(ks[14], (DEPTH, SSM_GROUPS), f32,
                                    math.log(DT_MIN), math.log(DT_MAX))
    ssm_B_re = nrm(ks[15], (DEPTH, SSM_GROUPS, SSM_STATE, SSM_GROUP), (2 * SSM_GROUP) ** -0.5)
    ssm_B_im = nrm(ks[16], (DEPTH, SSM_GROUPS, SSM_STATE, SSM_GROUP), (2 * SSM_GROUP) ** -0.5)
    ssm_C_re = nrm(ks[17], (DEPTH, SSM_GROUPS, SSM_GROUP, SSM_STATE), (2 * SSM_STATE) ** -0.5 * 4.0)
    ssm_C_im = nrm(ks[18], (DEPTH, SSM_GROUPS, SSM_GROUP, SSM_STATE), (2 * SSM_STATE) ** -0.5 * 4.0)
    ssm_D = nrm(ks[19], (DEPTH, SSM_GROUPS, SSM_GROUP), 1.0)
    ssm_glu_w = nrm(ks[20], (DEPTH, SSM_WIDTH, SSM_WIDTH), SSM_WIDTH ** -0.5)
    ssm_glu_b = nrm(ks[21], (DEPTH, SSM_WIDTH), 0.01)
    kk = jax.random.split(ks[22], 3)
    proj_attn = nrm(kk[0], (DEPTH, ATTN_HEADS * ATTN_V_DIM, D_MODEL), (ATTN_HEADS * ATTN_V_DIM) ** -0.5)
    proj_ssm = nrm(kk[1], (DEPTH, SSM_WIDTH, D_MODEL), SSM_WIDTH ** -0.5)
    w_out = nrm(kk[2], (DEPTH, D_MODEL, D_MODEL), D_MODEL ** -0.5)
    return {"x": x, "norm_gain": norm_gain, "w_in": w_in, "merge_gate_b": merge_gate_b,
            "q_norm_gain": q_norm_gain, "k_norm_gain": k_norm_gain,
            "lambda_q1": lambda_q1, "lambda_k1": lambda_k1, "lambda_q2": lambda_q2, "lambda_k2": lambda_k2,
            "diff_subln_gain": diff_subln_gain, "rel_bias_table": rel_bias_table,
            "ssm_A_re": ssm_A_re, "ssm_A_im": ssm_A_im, "ssm_log_dt": ssm_log_dt,
            "ssm_B_re": ssm_B_re, "ssm_B_im": ssm_B_im, "ssm_C_re": ssm_C_re, "ssm_C_im": ssm_C_im,
            "ssm_D": ssm_D, "ssm_glu_w": ssm_glu_w, "ssm_glu_b": ssm_glu_b,
            "proj_attn": proj_attn, "proj_ssm": proj_ssm, "w_out": w_out}


def reference(x, norm_gain, w_in, merge_gate_b, q_norm_gain, k_norm_gain,
              lambda_q1, lambda_k1, lambda_q2, lambda_k2, diff_subln_gain, rel_bias_table,
              ssm_A_re, ssm_A_im, ssm_log_dt, ssm_B_re, ssm_B_im, ssm_C_re, ssm_C_im,
              ssm_D, ssm_glu_w, ssm_glu_b, proj_attn, proj_ssm, w_out):
    f32 = jnp.float32
    B, L = x.shape[0], x.shape[1]
    for layer in range(DEPTH):
        lam_init = 0.8 - 0.6 * math.exp(-0.3 * layer)
        h = rms_norm(x, norm_gain[layer])
        z = h @ w_in[layer]
        q, k, v, gate_a, u_s, gate_s, merge_logits = jnp.split(z, IN_SPLITS, axis=-1)
        q = rms_norm(q.reshape(B, L, ATTN_HEADS, 2, ATTN_SUB_DIM), q_norm_gain[layer])
        k = rms_norm(k.reshape(B, L, ATTN_HEADS, 2, ATTN_SUB_DIM), k_norm_gain[layer])
        v = v.reshape(B, L, ATTN_HEADS, ATTN_V_DIM)
        lam = (jnp.exp(jnp.sum(lambda_q1[layer].astype(f32) * lambda_k1[layer].astype(f32)))
               - jnp.exp(jnp.sum(lambda_q2[layer].astype(f32) * lambda_k2[layer].astype(f32)))
               + lam_init)
        o_a = diff_attention(q, k, v, lam, rel_bias_table, diff_subln_gain[layer], lam_init)
        o_a = o_a * jax.nn.silu(gate_a)
        o_s = s5_branch(u_s, ssm_A_re[layer], ssm_A_im[layer], ssm_log_dt[layer],
                        ssm_B_re[layer], ssm_B_im[layer], ssm_C_re[layer], ssm_C_im[layer],
                        ssm_D[layer], ssm_glu_w[layer], ssm_glu_b[layer])
        o_s = o_s * jax.nn.silu(gate_s)
        g = jax.nn.sigmoid((merge_logits + merge_gate_b[layer]).astype(f32)).astype(x.dtype)
        g_a, g_s = jnp.split(g, 2, axis=-1)
        merged = g_a * (o_a @ proj_attn[layer]) + g_s * (o_s @ proj_ssm[layer])
        x = x + merged @ w_out[layer]
    return x
```

```cpp
#define USE_NAIVE 1
#define FAST_P1 0
#define FAST_ATT 0
#define FAST_SSM 0
#define FAST_P4 0
#define FAST_P5 0
#define FAST_P6 0
#include <hip/hip_runtime.h>
#include <cstdio>
#include <cstdint>
#include <cmath>

constexpr int BATCH = 8, SEQ = 4096, DM = 1024, MTOK = BATCH * SEQ;
constexpr int NCOL = 5120;
constexpr int AW = 512, NH = 4, SD = 64, VD = 128, SW = 512, SGC = 16, NG = 32, SP = 64;
constexpr int TCH = 16;
constexpr int NCH = SEQ / TCH;
constexpr int ALD = 384;
constexpr float LOG2E = 1.4426950408889634f;
constexpr float LAM_INIT = 0.2f;

constexpr size_t MiB = 1u << 20;
constexpr size_t WS_CTL = 0, CTL_ZERO_BYTES = 1 * MiB;
constexpr size_t WS_TAB = 1 * MiB;
constexpr size_t WS_WIN = 2 * MiB;
constexpr size_t WS_GLUW = 12 * MiB;
constexpr size_t WS_PA = 13 * MiB;
constexpr size_t WS_PS = 14 * MiB;
constexpr size_t WS_WOUT = 15 * MiB;
constexpr size_t WS_W2 = 17 * MiB;
constexpr size_t WS_KW = 21 * MiB;
constexpr size_t WS_END = 27 * MiB;
constexpr size_t WS_XN = 64 * MiB;
constexpr size_t WS_OA = 64 * MiB, WS_G = 96 * MiB;
constexpr size_t WS_Q = 128 * MiB, WS_K = 160 * MiB;
constexpr size_t WS_T1 = 128 * MiB;
constexpr size_t WS_V = 192 * MiB;
constexpr size_t WS_GA = 224 * MiB;
constexpr size_t WS_OS = 224 * MiB;
constexpr size_t WS_U = 256 * MiB;
constexpr size_t WS_GS = 304 * MiB;
constexpr size_t WS_MG = 336 * MiB;
constexpr size_t WS_TOTAL = 464 * MiB;

constexpr int TB_LAM = 0;
constexpr int TB_M0 = 1;
constexpr int TB_CFAR = 4;
constexpr int TB_QG = 64;
constexpr int TB_KG = 128;
constexpr int TB_BIASL = 256;
constexpr int TB_LB16 = 2048;

typedef unsigned short bf16;
typedef unsigned v4u __attribute__((ext_vector_type(4)));
typedef unsigned v2u __attribute__((ext_vector_type(2)));

__host__ __device__ __forceinline__ unsigned f2bf(float f) { unsigned u = __builtin_bit_cast(unsigned, f); return (u + 0x7fffu + ((u >> 16) & 1u)) >> 16; }
__host__ __device__ __forceinline__ float bf2f(unsigned h) { return __builtin_bit_cast(float, (h & 0xffffu) << 16); }
__device__ __forceinline__ unsigned pk2(float lo, float hi) { return f2bf(lo) | (f2bf(hi) << 16); }

__host__ __device__ __forceinline__ size_t qk_index(int b, int h, int s, int t, int d) {
    return ((((size_t)((b * 4 + h) * 2 + s) * 64 + (t >> 6)) * 8 + (d >> 3)) * 64 + (t & 63)) * 8 + (d & 7);
}
__host__ __device__ __forceinline__ size_t v_index(int b, int h, int t, int dv) { return ((size_t)(b * 4 + h) * SEQ + t) * VD + dv; }
__host__ __device__ __forceinline__ size_t u_index(int b, int g, int t, int hc) { return ((size_t)(b * NG + g) * NCH + (t >> 4)) * ALD + (t & 15) * 16 + hc; }
__host__ __device__ __forceinline__ int rowmap_in(int n) {
    if (n >= 1024) return n;
    const int tile = n >> 8, ow = n & 255, wc = ow >> 6, rem = ow & 63, bj = rem >> 5, i = rem & 31;
    return tile * 256 + 128 * bj + 32 * wc + i;
}
__device__ __forceinline__ int rel_bucket(int rel) {
    const int side = rel > 0 ? 16 : 0; const int n = rel < 0 ? -rel : rel; int b;
    if (n < 8) b = n;
    else b = n >= 91 ? 15 : n >= 64 ? 14 : n >= 46 ? 13 : n >= 32 ? 12 : n >= 23 ? 11 : n >= 16 ? 10 : n >= 12 ? 9 : 8;
    return side + b;
}
__device__ __forceinline__ float sigmoidf_(float x) { return 1.0f / (1.0f + __expf(-x)); }
__device__ __forceinline__ float siluf_(float x) { return x / (1.0f + __expf(-x)); }
__device__ __forceinline__ float gelu_tanh(float x) {
    const float u = 0.7978845608028654f * (x + 0.044715f * x * x * x);
    const float e = __expf(-2.0f * u);
    return x / (1.0f + e);
}
__device__ __forceinline__ void sincos_d(double x, double& s, double& c) {
    const double TWO_PI = 6.283185307179586476925286766559;
    const double k = rint(x / TWO_PI); x -= k * TWO_PI;
    const double x2 = x * x; double term = x; s = x;
    for (int n = 1; n <= 16; ++n) { term *= -x2 / (double)((2 * n) * (2 * n + 1)); s += term; }
    term = 1.0; c = 1.0;
    for (int n = 1; n <= 16; ++n) { term *= -x2 / (double)((2 * n - 1) * (2 * n)); c += term; }
}
__device__ __forceinline__ double exp_d(double x) {
    int k = 0; double ax = x < 0 ? -x : x; while (ax > 0.25) { ax *= 0.5; ++k; }
    const double y = x / (double)(1 << k); double term = 1.0, s = 1.0;
    for (int n = 1; n <= 14; ++n) { term *= y / (double)n; s += term; }
    for (int i = 0; i < k; ++i) s *= s;
    return s;
}
struct SsmConst { double lbr, lbi, qr, qi; };
__device__ __forceinline__ SsmConst ssm_const(const float* A_re, const float* A_im, const float* log_dt, int g, int p) {
    const double dt = exp_d((double)log_dt[g]); const double ar = (double)A_re[g * SP + p], ai = (double)A_im[g * SP + p];
    const double dec = exp_d(ar * dt); double sn, cs; sincos_d(ai * dt, sn, cs);
    SsmConst r; r.lbr = dec * cs; r.lbi = dec * sn;
    const double nr = r.lbr - 1.0, ni = r.lbi, den = ar * ar + ai * ai;
    r.qr = (nr * ar + ni * ai) / den; r.qi = (ni * ar - nr * ai) / den; return r;
}
#define GAS __attribute__((address_space(1)))
#define LAS __attribute__((address_space(3)))
typedef float f32x4 __attribute__((ext_vector_type(4)));
typedef short bf16x8 __attribute__((ext_vector_type(8)));
typedef GAS unsigned gu32;
typedef GAS unsigned long long gu64;
#define RLX_AGENT __ATOMIC_RELAXED, __HIP_MEMORY_SCOPE_AGENT
#define LDS_WAIT() asm volatile("s_waitcnt lgkmcnt(0)" ::: "memory")
#define VM_WAIT() asm volatile("s_waitcnt vmcnt(0)" ::: "memory")
__device__ __forceinline__ unsigned long long rt() { return __builtin_amdgcn_s_memrealtime(); }
#define XB_TMO      128
#define XB_XCNT(j)  (256  + 64 * (j))
#define XB_XSUB(j)  (1280 + 64 * (j))
#define XB_XGEN(j)  (2304 + 64 * (j))
#define XB_TOP      3328
#define XB_TOPGEN   3392
#define XCD_BAR_WORDS 3456
#define XB_SPIN_CAP (1u << 18)

__device__ __forceinline__ unsigned xb_ld(unsigned* p)              { return __hip_atomic_load(p, __ATOMIC_RELAXED, __HIP_MEMORY_SCOPE_AGENT); }
__device__ __forceinline__ unsigned xb_add(unsigned* p, unsigned v) { return __hip_atomic_fetch_add(p, v, __ATOMIC_RELAXED, __HIP_MEMORY_SCOPE_AGENT); }
__device__ __forceinline__ unsigned xb_xcc_id() { return (unsigned)__builtin_amdgcn_s_getreg((3 << 11) | 20) & 0xFu; }
#define XB_SPIN(cond, bar) do { unsigned _sp = 0; while (cond) { __builtin_amdgcn_s_sleep(1); \
    if ((++_sp & 255u) == 0u) { if (xb_ld(&(bar)[XB_TMO])) break; if (_sp > XB_SPIN_CAP) { atomicAdd(&(bar)[XB_TMO], 1u); break; } } } } while (0)

struct XcdBarrier {
    unsigned* bar; unsigned x;
    volatile LAS unsigned* st;
};

__device__ __forceinline__ XcdBarrier xcd_barrier_post(unsigned* bar, volatile LAS unsigned* st) {
    XcdBarrier b; b.bar = bar; b.x = xb_xcc_id(); b.st = st;
    if (threadIdx.x == 0) (void)xb_add(&bar[XB_XCNT(b.x)], 1u);
    return b;
}
__device__ __forceinline__ void xcd_barrier_complete(unsigned* bar, unsigned x, unsigned& nloc, unsigned& nx) {
    const unsigned G = gridDim.x * gridDim.y * gridDim.z;
    unsigned sum, cnt, mine, sp = 0u;
    for (;;) {
        sum = 0u; cnt = 0u; mine = 0u;
#pragma unroll
        for (unsigned j = 0; j < 16; ++j) { const unsigned c = xb_ld(&bar[XB_XCNT(j)]); sum += c; cnt += (c > 0u) ? 1u : 0u; mine = (j == x) ? c : mine; }
        if (sum == G) break;
        __builtin_amdgcn_s_sleep(1);
        if ((++sp & 255u) == 0u) { if (xb_ld(&bar[XB_TMO])) break; if (sp > XB_SPIN_CAP) { atomicAdd(&bar[XB_TMO], 1u); break; } }
    }
    nloc = mine > 0u ? mine : 1u; nx = cnt > 0u ? cnt : 1u;
}

__device__ __forceinline__ void xcd_barrier(const XcdBarrier& b) {
    asm volatile("s_waitcnt vmcnt(0)" ::: "memory");
    __syncthreads();
    if (threadIdx.x == 0) {
        unsigned* bar = b.bar;
        __builtin_amdgcn_s_waitcnt(0);
        unsigned nloc = b.st[0], nx = b.st[1];
        if (nloc == 0u) { xcd_barrier_complete(bar, b.x, nloc, nx); b.st[0] = nloc; b.st[1] = nx; }
        const unsigned old = xb_add(&bar[XB_XSUB(b.x)], 1u);
        const unsigned gen = old / nloc;
        if (old + 1u == (gen + 1u) * nloc) {
            __builtin_amdgcn_fence(__ATOMIC_RELEASE, "agent");
            asm volatile("s_waitcnt vmcnt(0)" ::: "memory");
            const unsigned og = xb_add(&bar[XB_TOP], 1u);
            const unsigned tg = og / nx;
            if (og + 1u == (tg + 1u) * nx) xb_add(&bar[XB_TOPGEN], 1u);
            else XB_SPIN(xb_ld(&bar[XB_TOPGEN]) == tg, bar);
            __builtin_amdgcn_fence(__ATOMIC_ACQUIRE, "agent");
            xb_add(&bar[XB_XGEN(b.x)], 1u);
            asm volatile("s_waitcnt vmcnt(0)" ::: "memory");
        } else {
            XB_SPIN(xb_ld(&bar[XB_XGEN(b.x)]) == gen, bar);
            __builtin_amdgcn_fence(__ATOMIC_ACQUIRE, "agent");
            asm volatile("s_waitcnt vmcnt(0)" ::: "memory");
        }
    }
    __syncthreads();
}
namespace pg8 {
#define PG8_LAS __attribute__((address_space(3)))
typedef unsigned short bf16_t;
typedef short bf16x8 __attribute__((ext_vector_type(8)));
typedef float f32x4 __attribute__((ext_vector_type(4)));
typedef unsigned u32x4 __attribute__((ext_vector_type(4)));
constexpr int BM = 256, BK = 64, HALF = 128, HTB = HALF * BK * 2  , STAGE_BYTES = 8 * HTB, NXCD = 8, WGM = 8;

__host__ __device__ __forceinline__ int lds_byte(int r, int c) { const int st = (r >> 4) * 2 + (c >> 5), rr = r & 15, cc = c & 31, ob = rr * 64 + cc * 2; return st * 1024 + (ob ^ (((ob >> 9) & 1) << 5)); }
__host__ __device__ __forceinline__ void stage_rc(int b, int& R, int& C) { const int st = b / 1024, sb = b % 1024, swz = sb ^ (((sb >> 9) & 1) << 5); R = (st >> 1) * 16 + swz / 64; C = (st & 1) * 32 + (swz % 64) / 2; }
__host__ __device__ __forceinline__ int perm32(int rho) { const int n = rho >> 4, i = rho & 15; return 8 * (i >> 2) + 4 * n + (i & 3); }

struct Unit { int pm, pn; };
struct Gemm { const bf16_t* A; const bf16_t* Bt; int M, N, K, lda, ldb; };

struct StaticOrder {
    int nM, nN, nwg, G, c;
    __host__ __device__ void init(int M, int N, int G_, int c_) { nM = M / BM; nN = N / BM; nwg = nM * nN; G = G_; c = c_; }
    __host__ __device__ bool next(int i, Unit& u) const {
        const long L = (long)i * G + c; if (L >= nwg) return false;
        int wgid = (int)L; { const int q = nwg / NXCD, r = nwg % NXCD, xcd = wgid % NXCD, off = wgid / NXCD; wgid = (xcd < r ? xcd * (q + 1) : r * (q + 1) + (xcd - r) * q) + off; }
        const int nig = WGM * nN, gid = wgid / nig, fm = gid * WGM, gsz = (nM - fm) < WGM ? (nM - fm) : WGM;
        u.pm = fm + ((wgid % nig) % gsz); u.pn = (wgid % nig) / gsz; return true;
    }
    __device__ __forceinline__ void a_ready(const Unit&) const {}
    __device__ __forceinline__ void done(const Unit&) const {}
};

__device__ __forceinline__ unsigned cvt_pk_bf16(float lo, float hi) { unsigned r; asm volatile("v_cvt_pk_bf16_f32 %0, %1, %2" : "=v"(r) : "v"(lo), "v"(hi)); return r; }
typedef float f32x2 __attribute__((ext_vector_type(2)));
template <class Epi, class Sched, bool ALIGN_EPI = false, bool SP2 = false>
__device__ __forceinline__ void gemm_phase(PG8_LAS unsigned char* lds, const Gemm g, const Sched& S, const Epi& E) {
    const int tid = threadIdx.x, wid = __builtin_amdgcn_readfirstlane(tid >> 6), lane = tid & 63, wr = wid >> 2, wc = wid & 3, fr = lane & 15, fq = lane >> 4;
    const int K = g.K, nt = K / BK;
    unsigned voffA[2], voffB[2];
#pragma unroll
    for (int i = 0; i < 2; ++i) { int R, C; stage_rc(tid * 16 + i * 8192, R, C); const int Rb = Epi::PERM ? ((R & ~31) + perm32(R & 31)) : R;
        voffA[i] = (unsigned)(R * g.lda + C) * 2u; voffB[i] = (unsigned)(Rb * g.ldb + C) * 2u; }
    const size_t kstep = (size_t)(BK * 2);
    const size_t hstepA = (size_t)HALF * g.lda * 2, hstepB = (size_t)HALF * g.ldb * 2;
    const size_t tstepA = 2 * hstepA, tstepB = 2 * hstepB;
    const unsigned ldsw = (unsigned)wid * 1024u;
    const int aoff = lds_byte(wr * 64 + fr, fq * 8), boff = lds_byte(wc * 32 + fr, fq * 8);
#define PG8_SA(b, h) (((b) * 2 + (h)) * HTB)
#define PG8_SB(b, h) ((4 + (b) * 2 + (h)) * HTB)
#define PG8_STAGE(bufoff, gbase, voff) do { _Pragma("unroll") for (int _i = 0; _i < 2; ++_i) \
        __builtin_amdgcn_global_load_lds((const unsigned*)((const char*)(gbase) + (voff)[_i]), (PG8_LAS unsigned*)(lds + (bufoff) + ldsw + _i * 8192), 16, 0, 0); } while (0)
#define PG8_LDA(dst, b, h) do { _Pragma("unroll") for (int m = 0; m < 4; ++m) _Pragma("unroll") for (int k = 0; k < 2; ++k) dst[m][k] = *(const PG8_LAS bf16x8*)(lds + PG8_SA(b, h) + aoff + m * 2048 + k * 1024); } while (0)
#define PG8_LDB(dst, b, h) do { _Pragma("unroll") for (int n = 0; n < 2; ++n) _Pragma("unroll") for (int k = 0; k < 2; ++k) dst[n][k] = *(const PG8_LAS bf16x8*)(lds + PG8_SB(b, h) + boff + n * 2048 + k * 1024); } while (0)
#define PG8_MMA(ai, bj, At, Bt) do { __builtin_amdgcn_s_setprio(1); _Pragma("unroll") for (int m = 0; m < 4; ++m) _Pragma("unroll") for (int n = 0; n < 2; ++n) _Pragma("unroll") for (int k = 0; k < 2; ++k) \
        acc[ai][bj][m][n] = __builtin_amdgcn_mfma_f32_16x16x32_bf16(Bt[n][k], At[m][k], acc[ai][bj][m][n], 0, 0, 0); __builtin_amdgcn_s_setprio(0); } while (0)
#define PG8_WAIT_V(n) asm volatile("s_waitcnt vmcnt(" #n ")" ::: "memory")
#define PG8_WAIT_L(n) asm volatile("s_waitcnt lgkmcnt(" #n ")" ::: "memory")
#define PG8_BAR __builtin_amdgcn_s_barrier()
#define PG8_SCHED __builtin_amdgcn_sched_barrier(0)
    Unit cur, nxt; int ui = 0;
    if (!S.next(0, cur)) return;
    f32x4 acc[2][2][4][2];
#pragma unroll
    for (int a = 0; a < 2; ++a)
#pragma unroll
        for (int b = 0; b < 2; ++b)
#pragma unroll
            for (int m = 0; m < 4; ++m)
#pragma unroll
                for (int n = 0; n < 2; ++n) acc[a][b][m][n] = (f32x4){0.f, 0.f, 0.f, 0.f};
    bf16x8 At[4][2], B0[2][2], B1[2][2];
    const char* cA = (const char*)g.A + (size_t)cur.pm * tstepA; const char* cB = (const char*)g.Bt + (size_t)cur.pn * tstepB;
    S.a_ready(cur);
    if constexpr (SP2) {
        PG8_STAGE(PG8_SB(0, 0), cB, voffB); PG8_STAGE(PG8_SB(0, 1), cB + hstepB, voffB); PG8_STAGE(PG8_SA(0, 0), cA, voffA); PG8_STAGE(PG8_SA(0, 1), cA + hstepA, voffA);
        if (wr == 1) PG8_BAR;
        PG8_WAIT_V(2); PG8_BAR;
        PG8_STAGE(PG8_SB(1, 0), cB + kstep, voffB); PG8_STAGE(PG8_SA(1, 0), cA + kstep, voffA); PG8_STAGE(PG8_SB(1, 1), cB + hstepB + kstep, voffB);
        PG8_WAIT_V(6); PG8_BAR;
    } else {
        PG8_STAGE(PG8_SB(0, 0), cB, voffB); PG8_STAGE(PG8_SA(0, 0), cA, voffA); PG8_STAGE(PG8_SB(0, 1), cB + hstepB, voffB); PG8_STAGE(PG8_SA(0, 1), cA + hstepA, voffA);
        if (wr == 1) PG8_BAR;
        PG8_WAIT_V(4); PG8_BAR;
        PG8_STAGE(PG8_SB(1, 0), cB + kstep, voffB); PG8_STAGE(PG8_SA(1, 0), cA + kstep, voffA); PG8_STAGE(PG8_SB(1, 1), cB + hstepB + kstep, voffB);
        PG8_WAIT_V(6); PG8_BAR;
    }
    for (;;) {
        const bool has_next = S.next(ui + 1, nxt);
        const char* nA = has_next ? (const char*)g.A + (size_t)nxt.pm * tstepA : cA; const char* nB = has_next ? (const char*)g.Bt + (size_t)nxt.pn * tstepB : cB;
        for (int t = 0; t < nt; t += 2) {
            const bool last = (t == nt - 2);
            const char* a1 = cA + (size_t)(t + 1) * kstep;
            const char* a2 = last ? nA : cA + (size_t)(t + 2) * kstep; const char* b2 = last ? nB : cB + (size_t)(t + 2) * kstep;
            const char* a3 = a2 + kstep; const char* b3 = b2 + kstep;
            if (last && has_next) S.a_ready(nxt);
            if constexpr (SP2) {
            PG8_LDB(B0, 0, 0); PG8_LDB(B1, 0, 1); PG8_SCHED; PG8_LDA(At, 0, 0); PG8_STAGE(PG8_SA(1, 1), a1 + hstepA, voffA);
            PG8_WAIT_V(8); PG8_WAIT_L(0); PG8_BAR; PG8_MMA(0, 0, At, B0); PG8_MMA(0, 1, At, B1); PG8_BAR; PG8_SCHED;
            PG8_LDA(At, 0, 1); PG8_STAGE(PG8_SB(0, 0), b2, voffB); PG8_STAGE(PG8_SB(0, 1), b2 + hstepB, voffB); PG8_STAGE(PG8_SA(0, 0), a2, voffA);
            PG8_WAIT_V(8); PG8_WAIT_L(0); PG8_BAR; PG8_MMA(1, 0, At, B0); PG8_MMA(1, 1, At, B1); PG8_BAR; PG8_SCHED;
            PG8_LDB(B0, 1, 0); PG8_LDB(B1, 1, 1); PG8_SCHED; PG8_LDA(At, 1, 0); PG8_STAGE(PG8_SA(0, 1), a2 + hstepA, voffA);
            PG8_WAIT_V(8); PG8_WAIT_L(0); PG8_BAR; PG8_MMA(0, 0, At, B0); PG8_MMA(0, 1, At, B1); PG8_BAR; PG8_SCHED;
            PG8_LDA(At, 1, 1); PG8_STAGE(PG8_SB(1, 0), b3, voffB); PG8_STAGE(PG8_SB(1, 1), b3 + hstepB, voffB); PG8_STAGE(PG8_SA(1, 0), a3, voffA);
            PG8_WAIT_V(8); PG8_WAIT_L(0); PG8_BAR; PG8_MMA(1, 0, At, B0); PG8_MMA(1, 1, At, B1); PG8_BAR; PG8_SCHED;
            } else {
            PG8_LDB(B0, 0, 0); PG8_SCHED; PG8_LDA(At, 0, 0); PG8_STAGE(PG8_SA(1, 1), a1 + hstepA, voffA);
            PG8_WAIT_L(8); PG8_BAR; PG8_WAIT_L(0); PG8_MMA(0, 0, At, B0); PG8_BAR; PG8_SCHED;
            PG8_LDB(B1, 0, 1); PG8_STAGE(PG8_SB(0, 0), b2, voffB);
            PG8_BAR; PG8_WAIT_L(0); PG8_MMA(0, 1, At, B1); PG8_BAR;
            PG8_LDA(At, 0, 1); PG8_STAGE(PG8_SA(0, 0), a2, voffA);
            PG8_BAR; PG8_WAIT_L(0); PG8_MMA(1, 0, At, B0); PG8_BAR; PG8_SCHED;
            PG8_STAGE(PG8_SB(0, 1), b2 + hstepB, voffB);
            PG8_WAIT_V(6); PG8_BAR; PG8_MMA(1, 1, At, B1); PG8_BAR;
            PG8_LDB(B0, 1, 0); PG8_SCHED; PG8_LDA(At, 1, 0); PG8_STAGE(PG8_SA(0, 1), a2 + hstepA, voffA);
            PG8_WAIT_L(8); PG8_BAR; PG8_WAIT_L(0); PG8_MMA(0, 0, At, B0); PG8_BAR; PG8_SCHED;
            PG8_LDB(B1, 1, 1); PG8_STAGE(PG8_SB(1, 0), b3, voffB);
            PG8_BAR; PG8_WAIT_L(0); PG8_MMA(0, 1, At, B1); PG8_BAR;
            PG8_LDA(At, 1, 1); PG8_STAGE(PG8_SA(1, 0), a3, voffA);
            PG8_BAR; PG8_WAIT_L(0); PG8_MMA(1, 0, At, B0); PG8_BAR; PG8_SCHED;
            PG8_STAGE(PG8_SB(1, 1), b3 + hstepB, voffB);
            PG8_WAIT_V(6); PG8_BAR; PG8_MMA(1, 1, At, B1); PG8_BAR;
            }
        }
        if constexpr (ALIGN_EPI) { if (wr == 0) PG8_BAR; }
        if constexpr (!Epi::AFTER_DRAIN) { E(acc, cur, wr, wc, fr, fq); S.done(cur); }
        if (!has_next) break;
#pragma unroll
        for (int a = 0; a < 2; ++a)
#pragma unroll
            for (int b = 0; b < 2; ++b)
#pragma unroll
                for (int m = 0; m < 4; ++m)
#pragma unroll
                    for (int n = 0; n < 2; ++n) acc[a][b][m][n] = (f32x4){0.f, 0.f, 0.f, 0.f};
        cur = nxt; cA = nA; cB = nB; ++ui;
        if constexpr (ALIGN_EPI) { if (wr == 1) PG8_BAR; }
    }
    PG8_WAIT_V(0);
    if constexpr (!ALIGN_EPI) { if (wr == 0) PG8_BAR; }
    PG8_BAR;
    if constexpr (Epi::AFTER_DRAIN) { E.fused(acc, cur, wr, wc, fr, fq, lds, wid, lane); S.done(cur); }
#undef PG8_SA
#undef PG8_SB
#undef PG8_STAGE
#undef PG8_LDA
#undef PG8_LDB
#undef PG8_MMA
#undef PG8_WAIT_V
#undef PG8_WAIT_L
#undef PG8_BAR
#undef PG8_SCHED
}
}
constexpr int NWAVES = 8;
constexpr int RING_OFF = 0, RING_BYTES = 131072;
constexpr int LDSCTL_OFF = RING_BYTES, MISC_OFF = LDSCTL_OFF + 320;
constexpr int LDS_EXTRA_OFF = RING_BYTES + 1024;
constexpr int LDS_BYTES = 147456;
constexpr int CW_TMO = 0, CW_CODE = 1, CW_BAR = 4096;

struct Args { const float* in[25]; float* out; unsigned char* ws; int ph_lo, ph_hi; };

struct Frame {
    LAS unsigned char* lds;
    volatile LAS unsigned* MISC;
    gu32* ctl;
    int tid, lane, wave, vcu, G;
};

__device__ __forceinline__ float wave_sum(float v) {
#pragma unroll
    for (int o = 1; o < 64; o <<= 1) v += __shfl_xor(v, o);
    return v;
}
template <bool MAP> __device__ __forceinline__ void p0_transpose_item(const float* W, int K, int N, bf16* WT, LAS float* scr, int item, int lane) {
    const int nblk = N / 32, kb = item / nblk, nb = item % nblk, k0 = 64 * kb, n0 = 32 * nb;
#pragma unroll 8
    for (int i = 0; i < 32; ++i) { const int kk = 2 * i + (lane >> 5); scr[kk * 33 + (lane & 31)] = W[(size_t)(k0 + kk) * N + n0 + (lane & 31)]; }
    LDS_WAIT(); asm volatile("" ::: "memory");
    const int c = lane & 7;
#pragma unroll
    for (int j = 0; j < 4; ++j) { const int n = (lane >> 3) + 8 * j; const LAS float* s = scr + (8 * c) * 33 + n;
        v4u o; o.x = pk2(s[0 * 33], s[1 * 33]); o.y = pk2(s[2 * 33], s[3 * 33]); o.z = pk2(s[4 * 33], s[5 * 33]); o.w = pk2(s[6 * 33], s[7 * 33]);
        const int dr = MAP ? rowmap_in(n0 + n) : (n0 + n);
        *(GAS v4u*)(WT + (size_t)dr * K + k0 + 8 * c) = o; }
    LDS_WAIT(); asm volatile("" ::: "memory");
}
__device__ __forceinline__ void rms_row_to_bf16(int lane, const float* xrow, const float* gain, bf16* orow) {
    const GAS f32x4* xr = (const GAS f32x4*)xrow + lane; const GAS f32x4* gr = (const GAS f32x4*)gain + lane;
    f32x4 v[4]; float s = 0.f;
#pragma unroll
    for (int j = 0; j < 4; ++j) { v[j] = xr[64 * j]; s += (v[j].x * v[j].x + v[j].y * v[j].y) + (v[j].z * v[j].z + v[j].w * v[j].w); }
    const float rstd = 1.0f / sqrtf(wave_sum(s) * (1.f / DM) + 1e-6f);
    GAS unsigned long long* o8 = (GAS unsigned long long*)orow + lane;
#pragma unroll
    for (int j = 0; j < 4; ++j) { const f32x4 gg = gr[64 * j];
        o8[64 * j] = (unsigned long long)pk2(v[j].x * rstd * gg.x, v[j].y * rstd * gg.y) | ((unsigned long long)pk2(v[j].z * rstd * gg.z, v[j].w * rstd * gg.w) << 32); }
}
__device__ __forceinline__ void p0_ssm_group(Frame& F, const Args& args, int g) {
    LAS float* L = (LAS float*)(F.lds + RING_OFF);
    LAS float* pwr = L;
    LAS float* pwi = L + 17 * 64;
    LAS float* bbr = L + 34 * 64;
    LAS float* bbi = bbr + 1024;
    LAS float* cre = bbi + 1024;
    LAS float* cim = cre + 1024;
    LAS float* klag = cim + 1024;
    const int tid = F.tid; unsigned char* ws = args.ws;
    if (tid < 64) {
        const int p = tid; const SsmConst sc = ssm_const(args.in[12], args.in[13], args.in[14], g, p);
        double wr = 1.0, wi = 0.0;
        for (int j = 0; j <= 16; ++j) { pwr[j * 64 + p] = (float)wr; pwi[j * 64 + p] = (float)wi; const double nr = wr * sc.lbr - wi * sc.lbi, ni = wr * sc.lbi + wi * sc.lbr; wr = nr; wi = ni; }
        float* tab = (float*)(ws + WS_TAB);
        tab[TB_LB16 + (g * 64 + p) * 2 + 0] = pwr[16 * 64 + p]; tab[TB_LB16 + (g * 64 + p) * 2 + 1] = pwi[16 * 64 + p];
        for (int h = 0; h < 16; ++h) { const double br = args.in[15][(g * SP + p) * 16 + h], bi = args.in[16][(g * SP + p) * 16 + h];
            bbr[p * 16 + h] = (float)(sc.qr * br - sc.qi * bi); bbi[p * 16 + h] = (float)(sc.qr * bi + sc.qi * br); }
    }
    for (int i = tid; i < 1024; i += 512) { cre[i] = args.in[17][g * 1024 + i]; cim[i] = args.in[18][g * 1024 + i]; }
    __syncthreads();
    for (int idx = tid; idx < 4096; idx += 512) { const int j = idx >> 8, h = (idx >> 4) & 15, h2 = idx & 15; float s = 0.f;
        for (int p = 0; p < 64; ++p) { const float cr = cre[h * 64 + p], ci = cim[h * 64 + p], wr = pwr[j * 64 + p], wi = pwi[j * 64 + p];
            const float er = cr * wr - ci * wi, ei = cr * wi + ci * wr; s += er * bbr[p * 16 + h2] - ei * bbi[p * 16 + h2]; }
        if (j == 0 && h == h2) s += args.in[19][g * 16 + h];
        klag[idx] = s; }
    __syncthreads();
    bf16* W2 = (bf16*)(ws + WS_W2); bf16* KW = (bf16*)(ws + WS_KW);
    for (int task = tid; task < 256 * 32; task += 512) { const int n = task >> 5, k8 = task & 31, s = k8 >> 1; float v[8];
#pragma unroll
        for (int e = 0; e < 8; ++e) { const int h2 = 8 * (k8 & 1) + e; float val = 0.f;
            if (n < 128) { const int p = n & 63; const float wr = pwr[(15 - s) * 64 + p], wi = pwi[(15 - s) * 64 + p], br = bbr[p * 16 + h2], bi = bbi[p * 16 + h2];
                val = (n >> 6) ? (wr * bi + wi * br) : (wr * br - wi * bi); }
            v[e] = val; }
        v4u o; o.x = pk2(v[0], v[1]); o.y = pk2(v[2], v[3]); o.z = pk2(v[4], v[5]); o.w = pk2(v[6], v[7]);
        *(GAS v4u*)(W2 + (size_t)(g * 256 + n) * 256 + 8 * k8) = o; }
    for (int task = tid; task < 256 * 48; task += 512) { const int n = task / 48, k8 = task % 48, t = n >> 4, h = n & 15; float v[8];
#pragma unroll
        for (int e = 0; e < 8; ++e) { float val;
            if (k8 < 32) { const int s = k8 >> 1, h2 = 8 * (k8 & 1) + e; val = (s <= t) ? klag[((t - s) * 16 + h) * 16 + h2] : 0.f; }
            else { const int kk = 8 * (k8 - 32) + e, part = kk >> 6, p = kk & 63; const float wr = pwr[(t + 1) * 64 + p], wi = pwi[(t + 1) * 64 + p], cr = cre[h * 64 + p], ci = cim[h * 64 + p];
                val = part ? -(cr * wi + ci * wr) : (cr * wr - ci * wi); }
            v[e] = val; }
        v4u o; o.x = pk2(v[0], v[1]); o.y = pk2(v[2], v[3]); o.z = pk2(v[4], v[5]); o.w = pk2(v[6], v[7]);
        *(GAS v4u*)(KW + (size_t)(g * 256 + n) * ALD + 8 * k8) = o; }
    __syncthreads();
}
__device__ __forceinline__ void p0_attn_tables(Frame& F, const Args& args) {
    LAS float* L = (LAS float*)(F.lds + RING_OFF); float* tab = (float*)(args.ws + WS_TAB); const int tid = F.tid;
    if (tid == 0) {
        float s1 = 0.f, s2 = 0.f, mq = 0.f, mk = 0.f, mt = 0.f;
        for (int i = 0; i < 64; ++i) { s1 += args.in[6][i] * args.in[7][i]; s2 += args.in[8][i] * args.in[9][i]; mq = fmaxf(mq, fabsf(args.in[4][i])); mk = fmaxf(mk, fabsf(args.in[5][i])); }
        for (int i = 0; i < 128; ++i) mt = fmaxf(mt, fabsf(args.in[11][i]));
        const float m0 = 8.0f * mq * mk + mt;
        tab[TB_LAM] = expf(s1) - expf(s2) + LAM_INIT; tab[TB_M0] = m0; L[0] = m0;
    }
    __syncthreads();
    const float m0 = L[0];
    if (tid < 4) tab[TB_CFAR + tid] = (args.in[11][15 * 4 + tid] - m0) * LOG2E;
    if (tid < 64) { tab[TB_QG + tid] = args.in[4][tid] * 0.125f * LOG2E; tab[TB_KG + tid] = args.in[5][tid]; }
    for (int i = tid; i < 1024; i += 512) { const int h = i >> 8, idx = i & 255; tab[TB_BIASL + i] = (args.in[11][rel_bucket(idx - 192) * 4 + h] - m0) * LOG2E; }
    __syncthreads();
}
__device__ __forceinline__ void p0_prologue(Frame& F, const Args& args) {
    unsigned char* ws = args.ws;
    if (F.vcu < NG) p0_ssm_group(F, args, F.vcu);
    else if (F.vcu == NG) p0_attn_tables(F, args);
    LAS float* scr = (LAS float*)(F.lds + RING_OFF + F.wave * 16384);
    const int gw = F.vcu * NWAVES + F.wave, NGW = F.G * NWAVES;
    constexpr int I_IN = (DM / 64) * (NCOL / 32), I_GLU = (SW / 64) * (SW / 32), I_PA = (AW / 64) * (DM / 32), I_PS = (SW / 64) * (DM / 32), I_WO = (DM / 64) * (DM / 32);
    constexpr int NITEMS = I_IN + I_GLU + I_PA + I_PS + I_WO;
    for (int it = gw; it < NITEMS; it += NGW) {
        int r = it;
        if (r < I_IN) { p0_transpose_item<true>(args.in[2], DM, NCOL, (bf16*)(ws + WS_WIN), scr, r, F.lane); continue; } r -= I_IN;
        if (r < I_GLU) { p0_transpose_item<false>(args.in[20], SW, SW, (bf16*)(ws + WS_GLUW), scr, r, F.lane); continue; } r -= I_GLU;
        if (r < I_PA) { p0_transpose_item<false>(args.in[22], AW, DM, (bf16*)(ws + WS_PA), scr, r, F.lane); continue; } r -= I_PA;
        if (r < I_PS) { p0_transpose_item<false>(args.in[23], SW, DM, (bf16*)(ws + WS_PS), scr, r, F.lane); continue; } r -= I_PS;
        p0_transpose_item<false>(args.in[24], DM, DM, (bf16*)(ws + WS_WOUT), scr, r, F.lane);
    }
    for (int m = gw; m < MTOK; m += NGW) rms_row_to_bf16(F.lane, args.in[0] + (size_t)m * DM, args.in[1], (bf16*)(ws + WS_XN) + (size_t)m * DM);
}
#if USE_NAIVE
struct NArgs { const float* in[25]; float* out; unsigned char* ws; };
__device__ __forceinline__ void st_bf(bf16* p, size_t i, float v) { p[i] = (bf16)f2bf(v); }

template <int MODE> __global__ void __launch_bounds__(256) nk_gemm(NArgs a) {
    __shared__ float As[16][65], Bs[16][65], red[64][17];
    unsigned char* ws = a.ws; const float* tab = (const float*)(ws + WS_TAB);
    const bf16* A; const bf16* Bt; int K, lda;
    if (MODE == 1) { A = (const bf16*)(ws + WS_XN); Bt = (const bf16*)(ws + WS_WIN); K = 1024; lda = 1024; }
    else if (MODE == 3) { A = (const bf16*)(ws + WS_G); Bt = (const bf16*)(ws + WS_GLUW); K = 512; lda = 512; }
    else if (MODE == 4) { A = (const bf16*)(ws + WS_OA); Bt = (const bf16*)(ws + WS_PA); K = 512; lda = 512; }
    else if (MODE == 5) { A = (const bf16*)(ws + WS_OS); Bt = (const bf16*)(ws + WS_PS); K = 512; lda = 512; }
    else { A = (const bf16*)(ws + WS_T1); Bt = (const bf16*)(ws + WS_WOUT); K = 1024; lda = 1024; }
    const int tid = threadIdx.x, ty = tid >> 4, tx = tid & 15, m0 = blockIdx.y * 64, n0 = blockIdx.x * 64;
    float acc[4][4] = {};
    for (int k0 = 0; k0 < K; k0 += 16) {
        for (int i = tid; i < 1024; i += 256) { const int r = i >> 4, kk = i & 15;
            As[kk][r] = bf2f(A[(size_t)(m0 + r) * lda + k0 + kk]);
            const int n = n0 + r; const int br = (MODE == 1) ? rowmap_in(n) : n;
            Bs[kk][r] = bf2f(Bt[(size_t)br * K + k0 + kk]); }
        __syncthreads();
#pragma unroll
        for (int kk = 0; kk < 16; ++kk) { float av[4], bv[4];
#pragma unroll
            for (int i = 0; i < 4; ++i) { av[i] = As[kk][ty * 4 + i]; bv[i] = Bs[kk][tx * 4 + i]; }
#pragma unroll
            for (int i = 0; i < 4; ++i)
#pragma unroll
                for (int j = 0; j < 4; ++j) acc[i][j] += av[i] * bv[j]; }
        __syncthreads();
    }
    if (MODE == 1) {
        const int typ = n0 < 512 ? 0 : n0 < 1024 ? 1 : n0 < 1536 ? 2 : n0 < 2048 ? 3 : n0 < 2560 ? 4 : n0 < 3072 ? 5 : 6;
        float rstd[4] = {1.f, 1.f, 1.f, 1.f};
        if (typ <= 1) {
            for (int i = 0; i < 4; ++i) { float s = 0.f; for (int j = 0; j < 4; ++j) s += acc[i][j] * acc[i][j]; red[ty * 4 + i][tx] = s; }
            __syncthreads();
            for (int i = 0; i < 4; ++i) { float s = 0.f; for (int j = 0; j < 16; ++j) s += red[ty * 4 + i][j]; rstd[i] = rsqrtf(s * (1.0f / 64.0f) + 1e-6f); }
        }
        for (int i = 0; i < 4; ++i) { const int row = m0 + ty * 4 + i, b = row >> 12, t = row & 4095;
            for (int j = 0; j < 4; ++j) { const int n = n0 + tx * 4 + j; const float v = acc[i][j];
                if (typ == 0) { const int sh = n >> 6, d = n & 63; st_bf((bf16*)(ws + WS_Q), qk_index(b, sh >> 1, sh & 1, t, d), v * rstd[i] * tab[TB_QG + d]); }
                else if (typ == 1) { const int sh = (n - 512) >> 6, d = n & 63; st_bf((bf16*)(ws + WS_K), qk_index(b, sh >> 1, sh & 1, t, d), v * rstd[i] * tab[TB_KG + d]); }
                else if (typ == 2) { const int c = n - 1024; st_bf((bf16*)(ws + WS_V), v_index(b, c >> 7, t, c & 127), v); }
                else if (typ == 3) { st_bf((bf16*)(ws + WS_GA), (size_t)row * 512 + (n - 1536), siluf_(v)); }
                else if (typ == 4) { const int c = n - 2048; st_bf((bf16*)(ws + WS_U), u_index(b, c >> 4, t, c & 15), v); }
                else if (typ == 5) { st_bf((bf16*)(ws + WS_GS), (size_t)row * 512 + (n - 2560), siluf_(v)); }
                else { const int c = n - 3072; st_bf((bf16*)(ws + WS_MG), (size_t)row * 2048 + c, sigmoidf_(v + a.in[3][c])); } } }
    } else {
        for (int i = 0; i < 4; ++i) { const int row = m0 + ty * 4 + i;
            for (int j = 0; j < 4; ++j) { const int n = n0 + tx * 4 + j; const float v = acc[i][j];
                if (MODE == 3) { const float g = bf2f(((const bf16*)(ws + WS_G))[(size_t)row * 512 + n]); const float gs = bf2f(((const bf16*)(ws + WS_GS))[(size_t)row * 512 + n]);
                    st_bf((bf16*)(ws + WS_OS), (size_t)row * 512 + n, g * sigmoidf_(v + a.in[21][n]) * gs); }
                else if (MODE == 4) { const float ga = bf2f(((const bf16*)(ws + WS_MG))[(size_t)row * 2048 + n]); st_bf((bf16*)(ws + WS_T1), (size_t)row * 1024 + n, ga * v); }
                else if (MODE == 5) { const float gs = bf2f(((const bf16*)(ws + WS_MG))[(size_t)row * 2048 + 1024 + n]); bf16* T1 = (bf16*)(ws + WS_T1); const size_t ix = (size_t)row * 1024 + n; st_bf(T1, ix, bf2f(T1[ix]) + gs * v); }
                else { const size_t ix = (size_t)row * 1024 + n; a.out[ix] = a.in[0][ix] + v; } } }
    }
}

__global__ void __launch_bounds__(256) nk_attn(NArgs a) {
    __shared__ float Qs[2][16][64], Ps[2][16][65];
    unsigned char* ws = a.ws; const float* tab = (const float*)(ws + WS_TAB);
    const bf16* Q = (const bf16*)(ws + WS_Q); const bf16* Kb = (const bf16*)(ws + WS_K); const bf16* V = (const bf16*)(ws + WS_V);
    const int tid = threadIdx.x, ql = tid >> 4, part = tid & 15, q0 = blockIdx.x * 16, h = blockIdx.y, b = blockIdx.z;
    const float m0 = tab[TB_M0], lam = tab[TB_LAM];
    for (int i = tid; i < 2048; i += 256) { const int s = i >> 10, q = (i >> 6) & 15, d = i & 63; Qs[s][q][d] = bf2f(Q[qk_index(b, h, s, q0 + q, d)]); }
    __syncthreads();
    const int ntile = (q0 >> 6) + 1;
    float o[2][8] = {}; float lacc[2] = {0.f, 0.f};
    for (int kt = 0; kt < ntile; ++kt) {
        for (int i = tid; i < 2048; i += 256) { const int s = i >> 10, q = (i >> 6) & 15, k = i & 63, key = kt * 64 + k;
            float dot = 0.f; for (int d = 0; d < 64; ++d) dot += Qs[s][q][d] * bf2f(Kb[qk_index(b, h, s, key, d)]);
            const float bias = (a.in[11][rel_bucket(key - (q0 + q)) * 4 + h] - m0) * LOG2E;
            Ps[s][q][k] = exp2f(dot + bias); }
        __syncthreads();
        for (int s = 0; s < 2; ++s) {
            for (int k = part * 4; k < part * 4 + 4; ++k) lacc[s] += Ps[s][ql][k];
            for (int k = 0; k < 64; ++k) { const float p = Ps[s][ql][k]; const bf16* vr = V + v_index(b, h, kt * 64 + k, part * 8);
                for (int j = 0; j < 8; ++j) o[s][j] += p * bf2f(vr[j]); } }
        __syncthreads();
    }
    for (int s = 0; s < 2; ++s) for (int off = 1; off < 16; off <<= 1) lacc[s] += __shfl_xor(lacc[s], off);
    float ov[8], ss = 0.f;
    for (int j = 0; j < 8; ++j) { ov[j] = o[0][j] / lacc[0] - lam * o[1][j] / lacc[1]; ss += ov[j] * ov[j]; }
    for (int off = 1; off < 16; off <<= 1) ss += __shfl_xor(ss, off);
    const float rstd = rsqrtf(ss * (1.0f / 128.0f) + 1e-6f);
    const size_t row = (size_t)b * SEQ + q0 + ql;
    for (int j = 0; j < 8; ++j) { const int dv = part * 8 + j; const float ga = bf2f(((const bf16*)(ws + WS_GA))[row * 512 + h * 128 + dv]);
        st_bf((bf16*)(ws + WS_OA), row * 512 + h * 128 + dv, ov[j] * rstd * a.in[10][dv] * (1.0f - LAM_INIT) * ga); }
}

__global__ void __launch_bounds__(64) nk_ssm(NArgs a) {
    __shared__ float X[64][129], Us[64][16], cre[16][64], cim[16][64], bbr[64][17], bbi[64][17];
    unsigned char* ws = a.ws; const bf16* U = (const bf16*)(ws + WS_U); bf16* G = (bf16*)(ws + WS_G);
    const int p = threadIdx.x, bg = blockIdx.x, b = bg >> 5, g = bg & 31;
    const SsmConst sc = ssm_const(a.in[12], a.in[13], a.in[14], g, p);
    for (int h = 0; h < 16; ++h) { const double br = a.in[15][(g * SP + p) * 16 + h], bi = a.in[16][(g * SP + p) * 16 + h]; bbr[p][h] = (float)(sc.qr * br - sc.qi * bi); bbi[p][h] = (float)(sc.qr * bi + sc.qi * br); }
    for (int i = p; i < 1024; i += 64) { cre[i >> 6][i & 63] = a.in[17][g * 1024 + i]; cim[i >> 6][i & 63] = a.in[18][g * 1024 + i]; }
    const float lbr = (float)sc.lbr, lbi = (float)sc.lbi; float xr = 0.f, xi = 0.f;
    for (int c0 = 0; c0 < SEQ; c0 += 64) {
        __syncthreads();
        for (int i = p; i < 1024; i += 64) Us[i >> 4][i & 15] = bf2f(U[u_index(b, g, c0 + (i >> 4), i & 15)]);
        __syncthreads();
#pragma unroll 1
        for (int tt = 0; tt < 64; ++tt) { float br = 0.f, bi = 0.f;
#pragma unroll 4
            for (int h = 0; h < 16; ++h) { br += bbr[p][h] * Us[tt][h]; bi += bbi[p][h] * Us[tt][h]; }
            const float nr = lbr * xr - lbi * xi + br, ni = lbr * xi + lbi * xr + bi; xr = nr; xi = ni; X[tt][p] = xr; X[tt][64 + p] = xi; }
        __syncthreads();
#pragma unroll 1
        for (int h = 0; h < 16; ++h) { float y = a.in[19][g * 16 + h] * Us[p][h];
#pragma unroll 4
            for (int pp = 0; pp < 64; ++pp) y += cre[h][pp] * X[p][pp] - cim[h][pp] * X[p][64 + pp];
            st_bf(G, ((size_t)b * SEQ + c0 + p) * 512 + g * 16 + h, gelu_tanh(y)); }
    }
}
#endif
__global__ void __launch_bounds__(NWAVES * 64, 2) mega_fwd(Args args) {
    extern __shared__ __attribute__((aligned(16))) unsigned char lds[];
    Frame F;
    F.lds = (LAS unsigned char*)lds;
    F.MISC = (volatile LAS unsigned*)(F.lds + MISC_OFF);
    F.tid = threadIdx.x; F.lane = F.tid & 63; F.wave = __builtin_amdgcn_readfirstlane(F.tid >> 6);
    F.G = gridDim.x; { const int bx = blockIdx.x; F.vcu = (F.G % 8 == 0) ? (bx % 8) * (F.G / 8) + bx / 8 : bx; }
    unsigned char* ws = args.ws;
    F.ctl = (gu32*)(ws + WS_CTL);
    for (int u = F.tid; u < (LDS_BYTES - LDSCTL_OFF) / 4; u += NWAVES * 64) ((LAS unsigned*)(F.lds + LDSCTL_OFF))[u] = 0u;
    __syncthreads();
    const int lo = args.ph_lo, hi = args.ph_hi;
    XcdBarrier bar; bar.bar = (unsigned*)(F.ctl + CW_BAR); bar.x = 0; bar.st = nullptr;
    if (hi - lo > 1) bar = xcd_barrier_post((unsigned*)(F.ctl + CW_BAR), F.MISC + 8);
#define IN(k) (lo <= (k) && (k) < hi)
#define BOTH(k) (IN(k) && IN((k) + 1))
    if (IN(0)) { p0_prologue(F, args); if (BOTH(0)) xcd_barrier(bar); }
#if FAST_P1
    if (IN(1)) { phase_inproj(F, args); if (BOTH(1)) xcd_barrier(bar); }
#endif
#if FAST_ATT
    if (IN(2)) { phase_attn(F, args, (char*)lds); }
#endif
#if FAST_SSM
    if (IN(3)) { phase_ssm(F, args); if (BOTH(3)) xcd_barrier(bar); }
#endif
#if FAST_P4
    if (IN(4)) { phase_glu_t1(F, args); if (BOTH(4)) xcd_barrier(bar); }
#endif
#if FAST_P5
    if (IN(5)) { phase_merge(F, args); if (BOTH(5)) xcd_barrier(bar); }
#endif
#if FAST_P6
    if (IN(6)) { phase_out(F, args); }
#endif
#undef IN
#undef BOTH
}

extern "C" void kernel_launch(void* const* d_in, const int* in_sizes, int n_in, void* d_out, int out_size, void* d_ws, size_t ws_size, hipStream_t stream) {
    static int grid = 0;
    if (grid == 0) {
        if (n_in != 25 || in_sizes[0] != MTOK * DM || out_size != MTOK * DM || ws_size < WS_TOTAL) { fprintf(stderr, "kernel_launch: unexpected shapes/workspace (n_in %d, in0 %d, out %d, ws %zu)\n", n_in, n_in > 0 ? in_sizes[0] : -1, out_size, ws_size); grid = -1; return; }
        int dev = 0, cus = 0, per_cu = 0;
        if (hipGetDevice(&dev) != hipSuccess || hipDeviceGetAttribute(&cus, hipDeviceAttributeMultiprocessorCount, dev) != hipSuccess) { grid = -1; return; }
        if (hipFuncSetAttribute((const void*)mega_fwd, hipFuncAttributeMaxDynamicSharedMemorySize, LDS_BYTES) != hipSuccess) { fprintf(stderr, "kernel_launch: hipFuncSetAttribute failed\n"); grid = -1; return; }
        if (hipOccupancyMaxActiveBlocksPerMultiprocessor(&per_cu, (const void*)mega_fwd, NWAVES * 64, LDS_BYTES) != hipSuccess || per_cu < 1) fprintf(stderr, "kernel_launch: occupancy query reports %d\n", per_cu);
        (void)hipGetLastError();
        grid = cus;
    }
    if (grid < 0) return;
    if (hipMemsetAsync((char*)d_ws + WS_CTL, 0, CTL_ZERO_BYTES, stream) != hipSuccess) return;
    Args a{};
    for (int i = 0; i < 25; ++i) a.in[i] = (const float*)d_in[i];
    a.out = (float*)d_out; a.ws = (unsigned char*)d_ws;
#if USE_NAIVE
    NArgs na{}; for (int i = 0; i < 25; ++i) na.in[i] = (const float*)d_in[i]; na.out = (float*)d_out; na.ws = (unsigned char*)d_ws;
#define MEGA(lo_, hi_) do { a.ph_lo = (lo_); a.ph_hi = (hi_); hipLaunchKernelGGL(mega_fwd, dim3(grid), dim3(NWAVES * 64), LDS_BYTES, stream, a); } while (0)
    MEGA(0, 1);
#if FAST_P1
    MEGA(1, 2);
#else
    hipLaunchKernelGGL(nk_gemm<1>, dim3(NCOL / 64, MTOK / 64), dim3(256), 0, stream, na);
#endif
#if FAST_ATT
    MEGA(2, 3);
#else
    hipLaunchKernelGGL(nk_attn, dim3(SEQ / 16, NH, BATCH), dim3(256), 0, stream, na);
#endif
#if FAST_SSM
    MEGA(3, 4);
#else
    hipLaunchKernelGGL(nk_ssm, dim3(BATCH * NG), dim3(64), 0, stream, na);
#endif
#if FAST_P4
    MEGA(4, 5);
#else
    hipLaunchKernelGGL(nk_gemm<3>, dim3(512 / 64, MTOK / 64), dim3(256), 0, stream, na);
    hipLaunchKernelGGL(nk_gemm<4>, dim3(1024 / 64, MTOK / 64), dim3(256), 0, stream, na);
#endif
#if FAST_P5
    MEGA(5, 6);
#else
    hipLaunchKernelGGL(nk_gemm<5>, dim3(1024 / 64, MTOK / 64), dim3(256), 0, stream, na);
#endif
#if FAST_P6
    MEGA(6, 7);
#else
    hipLaunchKernelGGL(nk_gemm<6>, dim3(1024 / 64, MTOK / 64), dim3(256), 0, stream, na);
#endif
#undef MEGA
#else
    a.ph_lo = 0; a.ph_hi = 7;
    hipLaunchKernelGGL(mega_fwd, dim3(grid), dim3(NWAVES * 64), LDS_BYTES, stream, a);
#endif
    const hipError_t le = hipPeekAtLastError();
    if (le != hipSuccess) fprintf(stderr, "kernel_launch: launch failed: %s\n", hipGetErrorName(le));
}
```

```cpp
#define USE_NAIVE 0
#define FAST_P1 1
#define FAST_ATT 1
#define FAST_SSM 1
#define FAST_P4 1
#define FAST_P5 1
#define FAST_P6 1

#include <hip/hip_runtime.h>
#include <cstdio>
#include <cstdint>
#include <cmath>

constexpr int BATCH = 8, SEQ = 4096, DM = 1024, MTOK = BATCH * SEQ;
constexpr int NCOL = 5120;
constexpr int AW = 512, NH = 4, SD = 64, VD = 128, SW = 512, SGC = 16, NG = 32, SP = 64;
constexpr int TCH = 16;
constexpr int NCH = SEQ / TCH;
constexpr int ALD = 384;
constexpr float LOG2E = 1.4426950408889634f;
constexpr float LAM_INIT = 0.2f;

constexpr size_t MiB = 1u << 20;
constexpr size_t WS_CTL = 0, CTL_ZERO_BYTES = 256 * 1024;
constexpr size_t WS_TAB = 1 * MiB;
constexpr size_t WS_WIN = 2 * MiB;
constexpr size_t WS_GLUW = 12 * MiB;
constexpr size_t WS_PAS = 13 * MiB;
constexpr size_t WS_WOUT = 15 * MiB;
constexpr size_t WS_W2 = 17 * MiB;
constexpr size_t WS_KW = 21 * MiB;
constexpr size_t WS_G = 27 * MiB;
constexpr size_t WS_XN = 64 * MiB;
constexpr size_t WS_OAS = 64 * MiB;
constexpr size_t WS_Q = 128 * MiB;
constexpr size_t QKB = 4194304, QKK = 2097152;
constexpr size_t WS_MRG = 128 * MiB;
constexpr size_t WS_V = 192 * MiB;
constexpr size_t WS_GA = 224 * MiB;
constexpr size_t WS_U = 256 * MiB;
constexpr size_t WS_GS = 304 * MiB;
constexpr size_t WS_MG = 336 * MiB;
constexpr size_t WS_TOTAL = 464 * MiB;

constexpr int TB_LAM = 0;
constexpr int TB_M0 = 1;
constexpr int TB_CFAR = 4;
constexpr int TB_QG = 64;
constexpr int TB_KG = 128;
constexpr int TB_BIASL = 256;
constexpr int TB_LB16 = 2048;

typedef unsigned short bf16;
typedef unsigned v4u __attribute__((ext_vector_type(4)));
typedef unsigned v2u __attribute__((ext_vector_type(2)));

__host__ __device__ __forceinline__ unsigned f2bf(float f) { unsigned u = __builtin_bit_cast(unsigned, f); return (u + 0x7fffu + ((u >> 16) & 1u)) >> 16; }
__host__ __device__ __forceinline__ float bf2f(unsigned h) { return __builtin_bit_cast(float, (h & 0xffffu) << 16); }
__device__ __forceinline__ unsigned pk2(float lo, float hi) { return f2bf(lo) | (f2bf(hi) << 16); }

__host__ __device__ __forceinline__ size_t qk_index(int b, int h, int s, int t, int d) {
    return (size_t)b * QKB + ((((size_t)(h * 2 + s) * 64 + (t >> 6)) * 8 + (d >> 3)) * 64 + (t & 63)) * 8 + (d & 7);
}
__host__ __device__ __forceinline__ size_t v_index(int b, int h, int t, int dv) { return ((size_t)(b * 4 + h) * SEQ + t) * VD + dv; }
__host__ __device__ __forceinline__ size_t u_index(int b, int g, int t, int hc) { return ((size_t)(b * NG + g) * NCH + (t >> 4)) * ALD + (t & 15) * 16 + hc; }
__host__ __device__ __forceinline__ int rowmap_in(int n) {
    if (n >= 3072) { const int c = n - 3072, isS = c >> 10, ch = c & 1023; return 3072 + 256 * (ch >> 7) + 128 * isS + (ch & 127); }
    if (n >= 1024) return n;
    const int tile = n >> 8, ow = n & 255, wc = ow >> 6, rem = ow & 63, bj = rem >> 5, i = rem & 31;
    return tile * 256 + 128 * bj + 32 * wc + i;
}
__device__ __forceinline__ int rel_bucket(int rel) {
    const int side = rel > 0 ? 16 : 0; const int n = rel < 0 ? -rel : rel; int b;
    if (n < 8) b = n;
    else b = n >= 91 ? 15 : n >= 64 ? 14 : n >= 46 ? 13 : n >= 32 ? 12 : n >= 23 ? 11 : n >= 16 ? 10 : n >= 12 ? 9 : 8;
    return side + b;
}
__device__ __forceinline__ float sigmoidf_(float x) { return __builtin_amdgcn_rcpf(1.0f + __builtin_amdgcn_exp2f(-LOG2E * x)); }
__device__ __forceinline__ float siluf_(float x) { return x * __builtin_amdgcn_rcpf(1.0f + __builtin_amdgcn_exp2f(-LOG2E * x)); }
__device__ __forceinline__ float gelu_tanh(float x) {
    const float u = 0.7978845608028654f * (x + 0.044715f * x * x * x);
    const float e = __builtin_amdgcn_exp2f(-2.0f * LOG2E * u);
    return x * __builtin_amdgcn_rcpf(1.0f + e);
}
__device__ __forceinline__ void sincos_d(double x, double& s, double& c) {
    const double TWO_PI = 6.283185307179586476925286766559;
    const double k = rint(x / TWO_PI); x -= k * TWO_PI;
    const double x2 = x * x; double term = x; s = x;
#pragma unroll
    for (int n = 1; n <= 16; ++n) { term *= -x2 * (1.0 / (double)((2 * n) * (2 * n + 1))); s += term; }
    term = 1.0; c = 1.0;
#pragma unroll
    for (int n = 1; n <= 16; ++n) { term *= -x2 * (1.0 / (double)((2 * n - 1) * (2 * n))); c += term; }
}
__device__ __forceinline__ double exp_d(double x) {
    int k = 0; double ax = x < 0 ? -x : x; while (ax > 0.25) { ax *= 0.5; ++k; }
    const double y = x / (double)(1 << k); double term = 1.0, s = 1.0;
#pragma unroll
    for (int n = 1; n <= 14; ++n) { term *= y * (1.0 / (double)n); s += term; }
    for (int i = 0; i < k; ++i) s *= s;
    return s;
}
struct SsmConst { double lbr, lbi, qr, qi; };
__device__ __forceinline__ SsmConst ssm_const(const float* A_re, const float* A_im, const float* log_dt, int g, int p) {
    const double dt = exp_d((double)log_dt[g]); const double ar = (double)A_re[g * SP + p], ai = (double)A_im[g * SP + p];
    const double dec = exp_d(ar * dt); double sn, cs; sincos_d(ai * dt, sn, cs);
    SsmConst r; r.lbr = dec * cs; r.lbi = dec * sn;
    const double nr = r.lbr - 1.0, ni = r.lbi, den = ar * ar + ai * ai;
    r.qr = (nr * ar + ni * ai) / den; r.qi = (ni * ar - nr * ai) / den; return r;
}
#define GAS __attribute__((address_space(1)))
#define LAS __attribute__((address_space(3)))
typedef float f32x4 __attribute__((ext_vector_type(4)));
typedef short bf16x8 __attribute__((ext_vector_type(8)));
typedef GAS unsigned gu32;
typedef GAS unsigned long long gu64;
#define RLX_AGENT __ATOMIC_RELAXED, __HIP_MEMORY_SCOPE_AGENT
#define LDS_WAIT() asm volatile("s_waitcnt lgkmcnt(0)" ::: "memory")
#define VM_WAIT() asm volatile("s_waitcnt vmcnt(0)" ::: "memory")
__device__ __forceinline__ unsigned long long rt() { return __builtin_amdgcn_s_memrealtime(); }
#define XB_TMO      128
#define XB_XCNT(j)  (256  + 64 * (j))
#define XB_XSUB(j)  (1280 + 64 * (j))
#define XB_XGEN(j)  (2304 + 64 * (j))
#define XB_TOP      3328
#define XB_TOPGEN   3392
#define XCD_BAR_WORDS 3456
#define XB_SPIN_CAP (1u << 18)

__device__ __forceinline__ unsigned xb_ld(unsigned* p)              { return __hip_atomic_load(p, __ATOMIC_RELAXED, __HIP_MEMORY_SCOPE_AGENT); }
__device__ __forceinline__ unsigned xb_add(unsigned* p, unsigned v) { return __hip_atomic_fetch_add(p, v, __ATOMIC_RELAXED, __HIP_MEMORY_SCOPE_AGENT); }
__device__ __forceinline__ unsigned xb_xcc_id() { return (unsigned)__builtin_amdgcn_s_getreg((3 << 11) | 20) & 0xFu; }
#define XB_SPIN(cond, bar) do { unsigned _sp = 0; while (cond) { __builtin_amdgcn_s_sleep(1); \
    if ((++_sp & 255u) == 0u) { if (xb_ld(&(bar)[XB_TMO])) break; if (_sp > XB_SPIN_CAP) { atomicAdd(&(bar)[XB_TMO], 1u); break; } } } } while (0)

struct XcdBarrier {
    unsigned* bar; unsigned x; unsigned nmemb;
    volatile LAS unsigned* st;
};

__device__ __forceinline__ XcdBarrier xcd_barrier_post(unsigned* bar, volatile LAS unsigned* st) {
    XcdBarrier b; b.bar = bar; b.x = xb_xcc_id(); b.st = st; b.nmemb = 0u;
    if (threadIdx.x == 0) (void)xb_add(&bar[XB_XCNT(b.x)], 1u);
    return b;
}
__device__ __forceinline__ void xcd_barrier_complete(unsigned* bar, unsigned x, unsigned& nloc, unsigned& nx, unsigned nmemb) {
    const unsigned G = nmemb ? nmemb : gridDim.x * gridDim.y * gridDim.z;
    unsigned sum, cnt, mine, sp = 0u;
    for (;;) {
        sum = 0u; cnt = 0u; mine = 0u;
#pragma unroll
        for (unsigned j = 0; j < 16; ++j) { const unsigned c = xb_ld(&bar[XB_XCNT(j)]); sum += c; cnt += (c > 0u) ? 1u : 0u; mine = (j == x) ? c : mine; }
        if (sum == G) break;
        __builtin_amdgcn_s_sleep(1);
        if ((++sp & 255u) == 0u) { if (xb_ld(&bar[XB_TMO])) break; if (sp > XB_SPIN_CAP) { atomicAdd(&bar[XB_TMO], 1u); break; } }
    }
    nloc = mine > 0u ? mine : 1u; nx = cnt > 0u ? cnt : 1u;
}

__device__ __forceinline__ void xcd_barrier(const XcdBarrier& b) {
    asm volatile("s_waitcnt vmcnt(0)" ::: "memory");
    __syncthreads();
    if (threadIdx.x == 0) {
        unsigned* bar = b.bar;
        __builtin_amdgcn_s_waitcnt(0);
        unsigned nloc = b.st[0], nx = b.st[1];
        if (nloc == 0u) { xcd_barrier_complete(bar, b.x, nloc, nx, b.nmemb); b.st[0] = nloc; b.st[1] = nx; }
        const unsigned old = xb_add(&bar[XB_XSUB(b.x)], 1u);
        const unsigned gen = old / nloc;
        if (old + 1u == (gen + 1u) * nloc) {
            if (!(b.nmemb != 0u && nx == 1u)) {
            __builtin_amdgcn_fence(__ATOMIC_RELEASE, "agent");
            }
            asm volatile("s_waitcnt vmcnt(0)" ::: "memory");
            const unsigned og = xb_add(&bar[XB_TOP], 1u);
            const unsigned tg = og / nx;
            if (og + 1u == (tg + 1u) * nx) xb_add(&bar[XB_TOPGEN], 1u);
            else XB_SPIN(xb_ld(&bar[XB_TOPGEN]) == tg, bar);
            __builtin_amdgcn_fence(__ATOMIC_ACQUIRE, "agent");
            xb_add(&bar[XB_XGEN(b.x)], 1u);
            asm volatile("s_waitcnt vmcnt(0)" ::: "memory");
        } else {
            XB_SPIN(xb_ld(&bar[XB_XGEN(b.x)]) == gen, bar);
            __builtin_amdgcn_fence(__ATOMIC_ACQUIRE, "agent");
            asm volatile("s_waitcnt vmcnt(0)" ::: "memory");
        }
    }
    __syncthreads();
}
#ifndef PG8_WGM
#define PG8_WGM 8
#endif
namespace pg8 {
#define PG8_LAS __attribute__((address_space(3)))
typedef unsigned short bf16_t;
typedef short bf16x8 __attribute__((ext_vector_type(8)));
typedef float f32x4 __attribute__((ext_vector_type(4)));
typedef unsigned u32x4 __attribute__((ext_vector_type(4)));
constexpr int BM = 256, BK = 64, HALF = 128, HTB = HALF * BK * 2  , STAGE_BYTES = 8 * HTB, NXCD = 8, WGM = PG8_WGM;

__host__ __device__ __forceinline__ int lds_byte(int r, int c) { const int st = (r >> 4) * 2 + (c >> 5), rr = r & 15, cc = c & 31, ob = rr * 64 + cc * 2; return st * 1024 + (ob ^ (((ob >> 9) & 1) << 5)); }
__host__ __device__ __forceinline__ void stage_rc(int b, int& R, int& C) { const int st = b / 1024, sb = b % 1024, swz = sb ^ (((sb >> 9) & 1) << 5); R = (st >> 1) * 16 + swz / 64; C = (st & 1) * 32 + (swz % 64) / 2; }
__host__ __device__ __forceinline__ int perm32(int rho) { const int n = rho >> 4, i = rho & 15; return 8 * (i >> 2) + 4 * n + (i & 3); }

struct Unit { int pm, pn; };
struct Gemm { const bf16_t* A; const bf16_t* Bt; int M, N, K, lda, ldb; };

struct StaticOrder {
    int nM, nN, nwg, G, c;
    __host__ __device__ void init(int M, int N, int G_, int c_) { nM = M / BM; nN = N / BM; nwg = nM * nN; G = G_; c = c_; }
    __host__ __device__ bool next(int i, Unit& u) const {
        const long L = (long)i * G + c; if (L >= nwg) return false;
        int wgid = (int)L; { const int q = nwg / NXCD, r = nwg % NXCD, xcd = wgid % NXCD, off = wgid / NXCD; wgid = (xcd < r ? xcd * (q + 1) : r * (q + 1) + (xcd - r) * q) + off; }
        const int nig = WGM * nN, gid = wgid / nig, fm = gid * WGM, gsz = (nM - fm) < WGM ? (nM - fm) : WGM;
        u.pm = fm + ((wgid % nig) % gsz); u.pn = (wgid % nig) / gsz; return true;
    }
    __device__ __forceinline__ void a_ready(const Unit&) const {}
    __device__ __forceinline__ void done(const Unit&) const {}
};

typedef float f32x2_cv __attribute__((ext_vector_type(2))); typedef __bf16 bf16x2_cv __attribute__((ext_vector_type(2)));
__device__ __forceinline__ unsigned cvt_pk_bf16(float lo, float hi) { f32x2_cv v = {lo, hi}; bf16x2_cv b = __builtin_convertvector(v, bf16x2_cv); return __builtin_bit_cast(unsigned, b); }
typedef float f32x2 __attribute__((ext_vector_type(2)));
template <class Epi, class Sched, bool ALIGN_EPI = false, bool SP2 = false, int KMID = 0>
__device__ __forceinline__ void gemm_phase(PG8_LAS unsigned char* lds, const Gemm g, const Sched& S, const Epi& E) {
    int tid_ = threadIdx.x; asm volatile("" : "+v"(tid_));
    const int tid = tid_, wid = __builtin_amdgcn_readfirstlane(tid >> 6), lane = tid & 63, wr = wid >> 2, wc = wid & 3, fr = lane & 15, fq = lane >> 4;
    const int K = g.K, nt = K / BK;
    unsigned voffA[2], voffB[2];
#pragma unroll
    for (int i = 0; i < 2; ++i) { int R, C; stage_rc(tid * 16 + i * 8192, R, C); const int Rb = Epi::PERM ? ((R & ~31) + perm32(R & 31)) : R;
        voffA[i] = (unsigned)(R * g.lda + C) * 2u; voffB[i] = (unsigned)(Rb * g.ldb + C) * 2u; }
    const size_t kstep = (size_t)(BK * 2);
    const size_t hstepA = (size_t)HALF * g.lda * 2, hstepB = (size_t)HALF * g.ldb * 2;
    const size_t tstepA = 2 * hstepA, tstepB = 2 * hstepB;
    const unsigned ldsw = (unsigned)wid * 1024u;
    const int aoff = lds_byte(wr * 64 + fr, fq * 8), boff = lds_byte(wc * 32 + fr, fq * 8);
#define PG8_SA(b, h) (((b) * 2 + (h)) * HTB)
#define PG8_SB(b, h) ((4 + (b) * 2 + (h)) * HTB)
#define PG8_STAGE(bufoff, gbase, voff) do { _Pragma("unroll") for (int _i = 0; _i < 2; ++_i) \
        __builtin_amdgcn_global_load_lds((const unsigned*)((const char*)(gbase) + (voff)[_i]), (PG8_LAS unsigned*)(lds + (bufoff) + ldsw + _i * 8192), 16, 0, 0); } while (0)
#define PG8_LDA(dst, b, h) do { _Pragma("unroll") for (int m = 0; m < 4; ++m) _Pragma("unroll") for (int k = 0; k < 2; ++k) dst[m][k] = *(const PG8_LAS bf16x8*)(lds + PG8_SA(b, h) + aoff + m * 2048 + k * 1024); } while (0)
#define PG8_LDB(dst, b, h) do { _Pragma("unroll") for (int n = 0; n < 2; ++n) _Pragma("unroll") for (int k = 0; k < 2; ++k) dst[n][k] = *(const PG8_LAS bf16x8*)(lds + PG8_SB(b, h) + boff + n * 2048 + k * 1024); } while (0)
#define PG8_MMA(ai, bj, At, Bt) do { __builtin_amdgcn_s_setprio(1); _Pragma("unroll") for (int m = 0; m < 4; ++m) _Pragma("unroll") for (int n = 0; n < 2; ++n) _Pragma("unroll") for (int k = 0; k < 2; ++k) \
        acc[ai][bj][m][n] = __builtin_amdgcn_mfma_f32_16x16x32_bf16(Bt[n][k], At[m][k], acc[ai][bj][m][n], 0, 0, 0); __builtin_amdgcn_s_setprio(0); } while (0)
#define PG8_WAIT_V(n) asm volatile("s_waitcnt vmcnt(" #n ")" ::: "memory")
#define PG8_WAIT_L(n) asm volatile("s_waitcnt lgkmcnt(" #n ")" ::: "memory")
#define PG8_BAR __builtin_amdgcn_s_barrier()
#define PG8_SCHED __builtin_amdgcn_sched_barrier(0)
    Unit cur, nxt; int ui = 0;
    if (!S.next(0, cur)) return;
    f32x4 acc[2][2][4][2];
#pragma unroll
    for (int a = 0; a < 2; ++a)
#pragma unroll
        for (int b = 0; b < 2; ++b)
#pragma unroll
            for (int m = 0; m < 4; ++m)
#pragma unroll
                for (int n = 0; n < 2; ++n) acc[a][b][m][n] = (f32x4){0.f, 0.f, 0.f, 0.f};
    bf16x8 At[4][2], B0[2][2], B1[2][2];
    const char* cA = (const char*)g.A + (size_t)cur.pm * tstepA; const char* cB = (const char*)g.Bt + (size_t)cur.pn * tstepB;
    S.a_ready(cur);
    if constexpr (SP2) {
        PG8_STAGE(PG8_SB(0, 0), cB, voffB); PG8_STAGE(PG8_SB(0, 1), cB + hstepB, voffB); PG8_STAGE(PG8_SA(0, 0), cA, voffA); PG8_STAGE(PG8_SA(0, 1), cA + hstepA, voffA);
        if (wr == 1) PG8_BAR;
        PG8_WAIT_V(2); PG8_BAR;
        PG8_STAGE(PG8_SB(1, 0), cB + kstep, voffB); PG8_STAGE(PG8_SA(1, 0), cA + kstep, voffA); PG8_STAGE(PG8_SB(1, 1), cB + hstepB + kstep, voffB);
        PG8_WAIT_V(6); PG8_BAR;
    } else {
        PG8_STAGE(PG8_SB(0, 0), cB, voffB); PG8_STAGE(PG8_SA(0, 0), cA, voffA); PG8_STAGE(PG8_SB(0, 1), cB + hstepB, voffB); PG8_STAGE(PG8_SA(0, 1), cA + hstepA, voffA);
        if (wr == 1) PG8_BAR;
        PG8_WAIT_V(4); PG8_BAR;
        PG8_STAGE(PG8_SB(1, 0), cB + kstep, voffB); PG8_STAGE(PG8_SA(1, 0), cA + kstep, voffA); PG8_STAGE(PG8_SB(1, 1), cB + hstepB + kstep, voffB);
        PG8_WAIT_V(6); PG8_BAR;
    }
    for (;;) {
        const bool has_next = S.next(ui + 1, nxt);
        const char* nA = has_next ? (const char*)g.A + (size_t)nxt.pm * tstepA : cA; const char* nB = has_next ? (const char*)g.Bt + (size_t)nxt.pn * tstepB : cB;
        for (int t = 0; t < nt; t += 2) {
            if constexpr (KMID != 0) { if (t == KMID / BK) E.mid(acc, cur, wr, wc, fr, fq); }
            const bool last = (t == nt - 2);
            const char* a1 = cA + (size_t)(t + 1) * kstep;
            const char* a2 = last ? nA : cA + (size_t)(t + 2) * kstep; const char* b2 = last ? nB : cB + (size_t)(t + 2) * kstep;
            const char* a3 = a2 + kstep; const char* b3 = b2 + kstep;
            if (last && has_next) S.a_ready(nxt);
            if constexpr (SP2) {
            PG8_LDB(B0, 0, 0); PG8_LDB(B1, 0, 1); PG8_SCHED; PG8_LDA(At, 0, 0); PG8_STAGE(PG8_SA(1, 1), a1 + hstepA, voffA);
            PG8_WAIT_V(8); PG8_WAIT_L(0); PG8_BAR; PG8_MMA(0, 0, At, B0); PG8_MMA(0, 1, At, B1); PG8_BAR; PG8_SCHED;
            PG8_LDA(At, 0, 1); PG8_STAGE(PG8_SB(0, 0), b2, voffB); PG8_STAGE(PG8_SB(0, 1), b2 + hstepB, voffB); PG8_STAGE(PG8_SA(0, 0), a2, voffA);
            PG8_WAIT_V(8); PG8_WAIT_L(0); PG8_BAR; PG8_MMA(1, 0, At, B0); PG8_MMA(1, 1, At, B1); PG8_BAR; PG8_SCHED;
            PG8_LDB(B0, 1, 0); PG8_LDB(B1, 1, 1); PG8_SCHED; PG8_LDA(At, 1, 0); PG8_STAGE(PG8_SA(0, 1), a2 + hstepA, voffA);
            PG8_WAIT_V(8); PG8_WAIT_L(0); PG8_BAR; PG8_MMA(0, 0, At, B0); PG8_MMA(0, 1, At, B1); PG8_BAR; PG8_SCHED;
            PG8_LDA(At, 1, 1); PG8_STAGE(PG8_SB(1, 0), b3, voffB); PG8_STAGE(PG8_SB(1, 1), b3 + hstepB, voffB); PG8_STAGE(PG8_SA(1, 0), a3, voffA);
            PG8_WAIT_V(8); PG8_WAIT_L(0); PG8_BAR; PG8_MMA(1, 0, At, B0); PG8_MMA(1, 1, At, B1); PG8_BAR; PG8_SCHED;
            } else {
            PG8_LDB(B0, 0, 0); PG8_SCHED; PG8_LDA(At, 0, 0); PG8_STAGE(PG8_SA(1, 1), a1 + hstepA, voffA);
            PG8_WAIT_L(8); PG8_BAR; PG8_WAIT_L(0); PG8_MMA(0, 0, At, B0); PG8_BAR; PG8_SCHED;
            PG8_LDB(B1, 0, 1); PG8_STAGE(PG8_SB(0, 0), b2, voffB);
            PG8_BAR; PG8_WAIT_L(0); PG8_MMA(0, 1, At, B1); PG8_BAR;
            PG8_LDA(At, 0, 1); PG8_STAGE(PG8_SA(0, 0), a2, voffA);
            PG8_BAR; PG8_WAIT_L(0); PG8_MMA(1, 0, At, B0); PG8_BAR; PG8_SCHED;
            PG8_STAGE(PG8_SB(0, 1), b2 + hstepB, voffB);
            PG8_WAIT_V(6); PG8_BAR; PG8_MMA(1, 1, At, B1); PG8_BAR;
            PG8_LDB(B0, 1, 0); PG8_SCHED; PG8_LDA(At, 1, 0); PG8_STAGE(PG8_SA(0, 1), a2 + hstepA, voffA);
            PG8_WAIT_L(8); PG8_BAR; PG8_WAIT_L(0); PG8_MMA(0, 0, At, B0); PG8_BAR; PG8_SCHED;
            PG8_LDB(B1, 1, 1); PG8_STAGE(PG8_SB(1, 0), b3, voffB);
            PG8_BAR; PG8_WAIT_L(0); PG8_MMA(0, 1, At, B1); PG8_BAR;
            PG8_LDA(At, 1, 1); PG8_STAGE(PG8_SA(1, 0), a3, voffA);
            PG8_BAR; PG8_WAIT_L(0); PG8_MMA(1, 0, At, B0); PG8_BAR; PG8_SCHED;
            PG8_STAGE(PG8_SB(1, 1), b3 + hstepB, voffB);
            PG8_WAIT_V(6); PG8_BAR; PG8_MMA(1, 1, At, B1); PG8_BAR;
            }
        }
        if constexpr (ALIGN_EPI) { if (wr == 0) PG8_BAR; }
#ifdef PROBE_EPI
        const unsigned long long te0_ = __builtin_amdgcn_s_memrealtime();
#endif
        if constexpr (!Epi::AFTER_DRAIN) { E(acc, cur, wr, wc, fr, fq); S.done(cur); }
#ifdef PROBE_EPI
        if (tid == 0) { volatile PG8_LAS unsigned* mm = (volatile PG8_LAS unsigned*)(lds + 131072 + 320); const unsigned long long d_ = __builtin_amdgcn_s_memrealtime() - te0_; const unsigned long long acc_ = (((unsigned long long)mm[27] << 32) | mm[26]) + d_; mm[26] = (unsigned)acc_; mm[27] = (unsigned)(acc_ >> 32); }
#endif
        if (!has_next) break;
#pragma unroll
        for (int a = 0; a < 2; ++a)
#pragma unroll
            for (int b = 0; b < 2; ++b)
#pragma unroll
                for (int m = 0; m < 4; ++m)
#pragma unroll
                    for (int n = 0; n < 2; ++n) acc[a][b][m][n] = (f32x4){0.f, 0.f, 0.f, 0.f};
        cur = nxt; cA = nA; cB = nB; ++ui;
        if constexpr (ALIGN_EPI) { if (wr == 1) PG8_BAR; }
    }
    PG8_WAIT_V(0);
    if constexpr (!ALIGN_EPI) { if (wr == 0) PG8_BAR; }
    PG8_BAR;
    if constexpr (Epi::AFTER_DRAIN) { E.fused(acc, cur, wr, wc, fr, fq, lds, wid, lane); S.done(cur); }
#undef PG8_SA
#undef PG8_SB
#undef PG8_STAGE
#undef PG8_LDA
#undef PG8_LDB
#undef PG8_MMA
#undef PG8_WAIT_V
#undef PG8_WAIT_L
#undef PG8_BAR
#undef PG8_SCHED
}
}
namespace pg8 {
#ifdef EPI_SC1
__device__ __forceinline__ void st16(void* p, const u32x4 v) { asm volatile("global_store_dwordx4 %0, %1, off sc1\n\ts_nop 1" :: "v"(p), "v"(v) : "memory"); }
#else
__device__ __forceinline__ void st16(void* p, const u32x4 v) { *(u32x4*)p = v; }
#endif
__device__ __forceinline__ u32x4 pack8(const f32x4 a, const f32x4 b) { u32x4 w; w.x = cvt_pk_bf16(a[0], a[1]); w.y = cvt_pk_bf16(a[2], a[3]); w.z = cvt_pk_bf16(b[0], b[1]); w.w = cvt_pk_bf16(b[2], b[3]); return w; }
__device__ __forceinline__ void unpack8(const u32x4 w, f32x4& a, f32x4& b) {
    a[0] = __builtin_bit_cast(float, w.x << 16); a[1] = __builtin_bit_cast(float, w.x & 0xffff0000u); a[2] = __builtin_bit_cast(float, w.y << 16); a[3] = __builtin_bit_cast(float, w.y & 0xffff0000u);
    b[0] = __builtin_bit_cast(float, w.z << 16); b[1] = __builtin_bit_cast(float, w.z & 0xffff0000u); b[2] = __builtin_bit_cast(float, w.w << 16); b[3] = __builtin_bit_cast(float, w.w & 0xffff0000u);
}
__device__ __forceinline__ f32x4 silu4(const f32x4 v) { f32x4 o; for (int e = 0; e < 4; ++e) o[e] = siluf_(v[e]); return o; }
__device__ __forceinline__ f32x4 sigm4(const f32x4 v) { f32x4 o; for (int e = 0; e < 4; ++e) o[e] = sigmoidf_(v[e]); return o; }
__device__ __forceinline__ f32x4 gelu4(const f32x4 v) { f32x4 o; for (int e = 0; e < 4; ++e) o[e] = gelu_tanh(v[e]); return o; }

struct EpiInProj {
    static constexpr bool PERM = true, AFTER_DRAIN = false;
    unsigned char* ws; const float* mgb; const float* subg;
    __device__ __forceinline__ void operator()(const f32x4 (&acc)[2][2][4][2], const Unit& u, int wr, int wc, int fr, int fq) const {
        asm volatile("" : "+v"(fr));
        const int pn = u.pn, row0 = u.pm * BM + wr * 64 + fr;
        if (pn < 4) {
            const float* tab = (const float*)(ws + WS_TAB) + (pn < 2 ? TB_QG : TB_KG);
            bf16_t* dst = (bf16_t*)(ws + WS_Q) + (pn < 2 ? 0 : QKK);
            const int sh = 4 * (pn & 1) + wc, h = sh >> 1, s = sh & 1;
            f32x4 g[2][2];
#pragma unroll
            for (int bj = 0; bj < 2; ++bj)
#pragma unroll
                for (int n = 0; n < 2; ++n) g[bj][n] = *(const f32x4*)(tab + 32 * bj + 8 * fq + 4 * n);
#pragma unroll
            for (int ai = 0; ai < 2; ++ai)
#pragma unroll
                for (int m = 0; m < 4; ++m) { const int row = row0 + ai * HALF + m * 16, b = row >> 12, t = row & 4095; float ss = 0.f;
#pragma unroll
                    for (int bj = 0; bj < 2; ++bj)
#pragma unroll
                        for (int n = 0; n < 2; ++n) { const f32x4 x = acc[ai][bj][m][n]; ss += (x[0] * x[0] + x[1] * x[1]) + (x[2] * x[2] + x[3] * x[3]); }
                    ss += __shfl_xor(ss, 16); ss += __shfl_xor(ss, 32);
                    const float rstd = rsqrtf(ss * (1.0f / 64.0f) + 1e-6f);
#pragma unroll
                    for (int bj = 0; bj < 2; ++bj) { const f32x4 v0 = acc[ai][bj][m][0] * rstd * g[bj][0], v1 = acc[ai][bj][m][1] * rstd * g[bj][1];
                        const size_t base = (size_t)b * QKB + ((((size_t)(h * 2 + s) * 64 + (t >> 6)) * 8 + (4 * bj + fq)) * 64 + (t & 63)) * 8;
                        st16(dst + base, pack8(v0, v1)); } }
        } else if (pn < 6) {
            bf16_t* dst = (bf16_t*)(ws + WS_V);
#pragma unroll
            for (int ai = 0; ai < 2; ++ai)
#pragma unroll
                for (int m = 0; m < 4; ++m) { const int row = row0 + ai * HALF + m * 16, b = row >> 12, t = row & 4095;
#pragma unroll
                    for (int bj = 0; bj < 2; ++bj) { const int h = 2 * (pn - 4) + bj;
                        st16(dst + ((size_t)(b * 4 + h) * SEQ + t) * VD + 32 * wc + 8 * fq, pack8(acc[ai][bj][m][0], acc[ai][bj][m][1])); } }
        } else if (pn < 8 || (pn >= 10 && pn < 12)) {
            bf16_t* dst = (bf16_t*)(ws + (pn < 8 ? WS_GA : WS_GS)); const int colt = 256 * (pn & 1) + 32 * wc + 8 * fq;
            f32x4 sg0 = (f32x4){1.f, 1.f, 1.f, 1.f}, sg1 = sg0;
            if (pn < 8) { sg0 = *(const f32x4*)(subg + 32 * wc + 8 * fq) * (1.0f - LAM_INIT); sg1 = *(const f32x4*)(subg + 32 * wc + 8 * fq + 4) * (1.0f - LAM_INIT); }
#pragma unroll
            for (int ai = 0; ai < 2; ++ai)
#pragma unroll
                for (int m = 0; m < 4; ++m) { const int row = row0 + ai * HALF + m * 16;
#pragma unroll
                    for (int bj = 0; bj < 2; ++bj) st16(dst + (size_t)row * 512 + colt + bj * HALF, pack8(silu4(acc[ai][bj][m][0]) * sg0, silu4(acc[ai][bj][m][1]) * sg1)); }
        } else if (pn < 10) {
            bf16_t* dst = (bf16_t*)(ws + WS_U);
#pragma unroll
            for (int ai = 0; ai < 2; ++ai)
#pragma unroll
                for (int m = 0; m < 4; ++m) { const int row = row0 + ai * HALF + m * 16, b = row >> 12, t = row & 4095;
#pragma unroll
                    for (int bj = 0; bj < 2; ++bj) { const int j = 256 * (pn - 8) + 128 * bj + 32 * wc + 8 * fq, g = j >> 4, hc = j & 15;
                        st16(dst + ((size_t)(b * NG + g) * NCH + (t >> 4)) * ALD + (t & 15) * 16 + hc, pack8(acc[ai][bj][m][0], acc[ai][bj][m][1])); } }
        } else {
            bf16_t* dst = (bf16_t*)(ws + WS_MG); const int ch0 = 128 * (pn - 12) + 32 * wc + 8 * fq;
            f32x4 ba[2], bs[2];
#pragma unroll
            for (int n = 0; n < 2; ++n) { ba[n] = *(const f32x4*)(mgb + ch0 + 4 * n); bs[n] = *(const f32x4*)(mgb + 1024 + ch0 + 4 * n); }
#pragma unroll
            for (int ai = 0; ai < 2; ++ai)
#pragma unroll
                for (int m = 0; m < 4; ++m) { const int row = row0 + ai * HALF + m * 16; f32x4 rr[2], gg[2];
#pragma unroll
                    for (int n = 0; n < 2; ++n) { const f32x4 a = sigm4(acc[ai][0][m][n] + ba[n]); gg[n] = sigm4(acc[ai][1][m][n] + bs[n]);
#pragma unroll
                        for (int e = 0; e < 4; ++e) rr[n][e] = a[e] * __builtin_amdgcn_rcpf(fmaxf(gg[n][e], 1e-30f)); }
                    st16(dst + (size_t)row * 2048 + ch0, pack8(rr[0], rr[1]));
                    st16(dst + (size_t)row * 2048 + 1024 + ch0, pack8(gg[0], gg[1])); }
        }
    }
};
struct EpiGlu {
    static constexpr bool PERM = true, AFTER_DRAIN = false;
    const bf16_t* G; const bf16_t* GS; bf16_t* OS; const float* glub;
    __device__ __forceinline__ void operator()(const f32x4 (&acc)[2][2][4][2], const Unit& u, int wr, int wc, int fr, int fq) const {
        asm volatile("" : "+v"(fr));
        const int row0 = u.pm * BM + wr * 64 + fr, colt = u.pn * BM + 32 * wc + 8 * fq;
        f32x4 bv[2][2];
#pragma unroll
        for (int bj = 0; bj < 2; ++bj)
#pragma unroll
            for (int n = 0; n < 2; ++n) bv[bj][n] = *(const f32x4*)(glub + colt + bj * HALF + 4 * n);
#pragma unroll
        for (int ai = 0; ai < 2; ++ai) { u32x4 gq[4][2], sq[4][2];
#pragma unroll
            for (int m = 0; m < 4; ++m)
#pragma unroll
                for (int bj = 0; bj < 2; ++bj) { const size_t ix = (size_t)(row0 + ai * HALF + m * 16) * 512 + colt + bj * HALF; gq[m][bj] = *(const u32x4*)(G + ix); sq[m][bj] = *(const u32x4*)(GS + ix); }
#pragma unroll
            for (int m = 0; m < 4; ++m) { const size_t ro = (size_t)(row0 + ai * HALF + m * 16) * 512;
#pragma unroll
                for (int bj = 0; bj < 2; ++bj) { f32x4 g0, g1, s0, s1; unpack8(gq[m][bj], g0, g1); unpack8(sq[m][bj], s0, s1);
                    st16(OS + 2 * ro + 512 + colt + bj * HALF, pack8(g0 * sigm4(acc[ai][bj][m][0] + bv[bj][0]) * s0, g1 * sigm4(acc[ai][bj][m][1] + bv[bj][1]) * s1)); } }
            asm volatile("" ::: "memory"); }
    }
};
struct EpiMerge {
    static constexpr bool PERM = true, AFTER_DRAIN = false;
    const bf16_t* MG; bf16_t* MRG;
    __device__ __forceinline__ void mid(f32x4 (&acc)[2][2][4][2], const Unit& u, int wr, int wc, int fr, int fq) const {
        asm volatile("" : "+v"(fr));
        const int row0 = u.pm * BM + wr * 64 + fr, colt = u.pn * BM + 32 * wc + 8 * fq;
#pragma unroll
        for (int ai = 0; ai < 2; ++ai)
#pragma unroll
            for (int m = 0; m < 4; ++m) { const size_t row = (size_t)(row0 + ai * HALF + m * 16);
#pragma unroll
                for (int bj = 0; bj < 2; ++bj) { const int col = colt + bj * HALF; f32x4 r0, r1; unpack8(*(const u32x4*)(MG + row * 2048 + col), r0, r1);
                    acc[ai][bj][m][0] *= r0; acc[ai][bj][m][1] *= r1; } }
    }
    __device__ __forceinline__ void operator()(const f32x4 (&acc)[2][2][4][2], const Unit& u, int wr, int wc, int fr, int fq) const {
        asm volatile("" : "+v"(fr));
        const int row0 = u.pm * BM + wr * 64 + fr, colt = u.pn * BM + 32 * wc + 8 * fq;
        u32x4 gv[2][4][2];
#pragma unroll
        for (int ai = 0; ai < 2; ++ai)
#pragma unroll
            for (int m = 0; m < 4; ++m)
#pragma unroll
                for (int bj = 0; bj < 2; ++bj) gv[ai][m][bj] = *(const u32x4*)(MG + (size_t)(row0 + ai * HALF + m * 16) * 2048 + 1024 + colt + bj * HALF);
#pragma unroll
        for (int ai = 0; ai < 2; ++ai)
#pragma unroll
            for (int m = 0; m < 4; ++m) { const size_t row = (size_t)(row0 + ai * HALF + m * 16);
#pragma unroll
                for (int bj = 0; bj < 2; ++bj) { const int col = colt + bj * HALF; f32x4 s0, s1; unpack8(gv[ai][m][bj], s0, s1);
                    st16(MRG + row * 1024 + col, pack8(s0 * acc[ai][bj][m][0], s1 * acc[ai][bj][m][1])); } }
    }
};
struct EpiOut {
    static constexpr bool PERM = true, AFTER_DRAIN = false;
    const float* x; float* out;
    __device__ __forceinline__ void operator()(const f32x4 (&acc)[2][2][4][2], const Unit& u, int wr, int wc, int fr, int fq) const {
        asm volatile("" : "+v"(fr));
        const int row0 = u.pm * BM + wr * 64 + fr, colt = u.pn * BM + 32 * wc + 8 * fq;
#pragma unroll
        for (int ai = 0; ai < 2; ++ai) { f32x4 xv[4][2][2];
#pragma unroll
            for (int m = 0; m < 4; ++m) { const size_t ro = (size_t)(row0 + ai * HALF + m * 16) * 1024;
#pragma unroll
                for (int bj = 0; bj < 2; ++bj)
#pragma unroll
                    for (int n = 0; n < 2; ++n) xv[m][bj][n] = *(const f32x4*)(x + ro + colt + bj * HALF + 4 * n); }
#pragma unroll
            for (int m = 0; m < 4; ++m) { const size_t ro = (size_t)(row0 + ai * HALF + m * 16) * 1024;
#pragma unroll
                for (int bj = 0; bj < 2; ++bj)
#pragma unroll
                    for (int n = 0; n < 2; ++n) *(f32x4*)(out + ro + colt + bj * HALF + 4 * n) = xv[m][bj][n] + acc[ai][bj][m][n]; }
            asm volatile("" ::: "memory"); }
    }
};
__device__ __forceinline__ int end_lds_idx(int k, int c) { return k * 128 + (c ^ ((k & 7) << 2)); }
struct EpiEnd {
    static constexpr bool PERM = true, AFTER_DRAIN = true;
    __device__ __forceinline__ void fused(f32x4 (&acc)[2][2][4][2], const Unit& u, int wr, int wc, int fr, int fq, PG8_LAS unsigned char* lds, int wid, int lane) const {
        PG8_LAS float* L = (PG8_LAS float*)lds;
#pragma unroll
        for (int ai = 0; ai < 2; ++ai)
#pragma unroll
            for (int m = 0; m < 4; ++m) { const int k = ai * HALF + wr * 64 + m * 16 + fr;
#pragma unroll
                for (int n = 0; n < 2; ++n) *(PG8_LAS f32x4*)(L + end_lds_idx(k, 32 * wc + 8 * fq + 4 * n)) = acc[ai][0][m][n]; }
    }
};
struct EpiY {
    static constexpr bool PERM = true, AFTER_DRAIN = false;
    bf16_t* G;
    __device__ __forceinline__ void operator()(const f32x4 (&acc)[2][2][4][2], const Unit& u, int wr, int wc, int fr, int fq) const {
        int pm_ = u.pm; asm volatile("" : "+s"(pm_), "+v"(fr));
        const int b = pm_ >> 5, g = pm_ & 31;
#pragma unroll
        for (int ai = 0; ai < 2; ++ai)
#pragma unroll
            for (int m = 0; m < 4; ++m) { const int k = ai * HALF + wr * 64 + m * 16 + fr;
#pragma unroll
                for (int bj = 0; bj < 2; ++bj) { const int ct = 128 * bj + 32 * wc + 8 * fq, tt = ct >> 4, hc = ct & 15;
                    st16(G + ((size_t)b * SEQ + 16 * k + tt) * 512 + g * 16 + hc, pack8(gelu4(acc[ai][bj][m][0]), gelu4(acc[ai][bj][m][1]))); }
                asm volatile("" ::: "memory"); }
    }
};
struct OneUnit { Unit u;
    __device__ __forceinline__ bool next(int i, Unit& o) const { if (i != 0) return false; o = u; return true; }
    __device__ __forceinline__ void a_ready(const Unit&) const {}
    __device__ __forceinline__ void done(const Unit&) const {}
};
}
constexpr int NWAVES = 8;
constexpr int RING_OFF = 0, RING_BYTES = 131072;
constexpr int LDSCTL_OFF = RING_BYTES, MISC_OFF = LDSCTL_OFF + 320;
constexpr int LDS_EXTRA_OFF = RING_BYTES + 1024;
constexpr int LDS_BYTES = 147456;
constexpr int CW_TMO = 0, CW_CODE = 1, CW_BAR = 4096, CW_ATTQ = 1024;

constexpr int CW_GBAR = 8192;

struct Args { const float* in[25]; float* out; unsigned char* ws; int ph_lo, ph_hi, li, pad; };

struct Frame {
    LAS unsigned char* lds;
    volatile LAS unsigned* MISC;
    gu32* ctl;
    int tid, lane, wave, vcu, G;
};

__device__ __forceinline__ float wave_sum(float v) {
#pragma unroll
    for (int o = 1; o < 64; o <<= 1) v += __shfl_xor(v, o);
    return v;
}
template <bool MAP> __device__ __forceinline__ void p0_transpose_item(const float* W, int K, int N, bf16* WT, int ldw, LAS float* scr, int item, int lane) {
    const int nblk = N / 32, kb = item / nblk, nb = item % nblk, k0 = 64 * kb, n0 = 32 * nb;
    f32x4 wv[8];
#pragma unroll
    for (int i = 0; i < 8; ++i) wv[i] = *(const GAS f32x4*)(W + (size_t)(k0 + 8 * i + (lane >> 3)) * N + n0 + 4 * (lane & 7));
#pragma unroll
    for (int i = 0; i < 8; ++i) { LAS float* d = scr + (8 * i + (lane >> 3)) * 33 + 4 * (lane & 7); d[0] = wv[i].x; d[1] = wv[i].y; d[2] = wv[i].z; d[3] = wv[i].w; }
    LDS_WAIT(); asm volatile("" ::: "memory");
    const int c = lane & 7;
#pragma unroll
    for (int j = 0; j < 4; ++j) { const int n = (lane >> 3) + 8 * j; const LAS float* s = scr + (8 * c) * 33 + n;
        v4u o; o.x = pk2(s[0 * 33], s[1 * 33]); o.y = pk2(s[2 * 33], s[3 * 33]); o.z = pk2(s[4 * 33], s[5 * 33]); o.w = pk2(s[6 * 33], s[7 * 33]);
        const int dr = MAP ? rowmap_in(n0 + n) : (n0 + n);
        *(GAS v4u*)(WT + (size_t)dr * ldw + k0 + 8 * c) = o; }
    LDS_WAIT(); asm volatile("" ::: "memory");
}
struct XnBatch { f32x4 v[4][4]; };
__device__ __forceinline__ void xn_load(XnBatch& B, int lane, const float* x, int m0, int mstride) {
#pragma unroll
    for (int r = 0; r < 4; ++r) { const GAS f32x4* xr = (const GAS f32x4*)(x + (size_t)(m0 + r * mstride) * DM) + lane;
#pragma unroll
        for (int j = 0; j < 4; ++j) B.v[r][j] = xr[64 * j]; }
}
__device__ __forceinline__ void xn_finish(const XnBatch& B, int lane, const float* gain, bf16* xn, int m0, int mstride) {
    const GAS f32x4* gr = (const GAS f32x4*)gain + lane;
    f32x4 gg[4];
#pragma unroll
    for (int j = 0; j < 4; ++j) gg[j] = gr[64 * j];
#pragma unroll
    for (int r = 0; r < 4; ++r) { float s = 0.f;
#pragma unroll
        for (int j = 0; j < 4; ++j) s += (B.v[r][j].x * B.v[r][j].x + B.v[r][j].y * B.v[r][j].y) + (B.v[r][j].z * B.v[r][j].z + B.v[r][j].w * B.v[r][j].w);
        const float rstd = 1.0f / sqrtf(wave_sum(s) * (1.f / DM) + 1e-6f);
        GAS unsigned long long* o8 = (GAS unsigned long long*)(xn + (size_t)(m0 + r * mstride) * DM) + lane;
#pragma unroll
        for (int j = 0; j < 4; ++j)
            o8[64 * j] = (unsigned long long)pk2(B.v[r][j].x * rstd * gg[j].x, B.v[r][j].y * rstd * gg[j].y) | ((unsigned long long)pk2(B.v[r][j].z * rstd * gg[j].z, B.v[r][j].w * rstd * gg[j].w) << 32); }
}
#define P0_SSM_LDS() LAS float* L = (LAS float*)(F.lds + RING_OFF); LAS float* pwr = L; LAS float* pwi = L + 17 * 64; LAS float* bbr = L + 34 * 64; LAS float* bbi = bbr + 1024; \
    LAS float* cre = bbi + 1024; LAS float* cim = cre + 1024; LAS float* klag = cim + 1024; const int tid = F.tid; unsigned char* ws = args.ws; (void)klag; (void)ws; (void)cim; (void)cre; (void)bbi; (void)bbr; (void)pwi; (void)pwr;
__device__ __forceinline__ void p0_ssm_step1(Frame& F, const Args& args, int g, int q) {
    P0_SSM_LDS()
    if (tid < 64) {
        const int p = tid; const SsmConst sc = ssm_const(args.in[12], args.in[13], args.in[14], g, p);
        double wr = 1.0, wi = 0.0;
        for (int j = 0; j <= 16; ++j) { pwr[j * 64 + p] = (float)wr; pwi[j * 64 + p] = (float)wi; const double nr = wr * sc.lbr - wi * sc.lbi, ni = wr * sc.lbi + wi * sc.lbr; wr = nr; wi = ni; }
        if (q == 0) { float* tab = (float*)(ws + WS_TAB); tab[TB_LB16 + (g * 64 + p) * 2 + 0] = pwr[16 * 64 + p]; tab[TB_LB16 + (g * 64 + p) * 2 + 1] = pwi[16 * 64 + p]; }
        for (int h = 0; h < 16; ++h) { const double br = args.in[15][(g * SP + p) * 16 + h], bi = args.in[16][(g * SP + p) * 16 + h];
            bbr[p * 16 + h] = (float)(sc.qr * br - sc.qi * bi); bbi[p * 16 + h] = (float)(sc.qr * bi + sc.qi * br); }
    }
    for (int i = tid; i < 1024; i += 512) { cre[i] = args.in[17][g * 1024 + i]; cim[i] = args.in[18][g * 1024 + i]; }
}
__device__ __forceinline__ void p0_ssm_klag(Frame& F, const Args& args, int g, int q) {
    P0_SSM_LDS()
    { const int j = tid >> 5, h = (tid >> 1) & 15, oc = tid & 1;
      if (j <= 2 * q + 1) { float s[8] = {0.f, 0.f, 0.f, 0.f, 0.f, 0.f, 0.f, 0.f};
        for (int p = 0; p < 64; ++p) { const float cr = cre[h * 64 + p], ci = cim[h * 64 + p], wr = pwr[j * 64 + p], wi = pwi[j * 64 + p];
            const float er = cr * wr - ci * wi, ei = cr * wi + ci * wr;
#pragma unroll
            for (int e = 0; e < 8; ++e) s[e] += er * bbr[p * 16 + 8 * oc + e] - ei * bbi[p * 16 + 8 * oc + e]; }
#pragma unroll
        for (int e = 0; e < 8; ++e) { const int h2 = 8 * oc + e; klag[(j * 16 + h) * 16 + h2] = s[e] + ((j == 0 && h == h2) ? args.in[19][g * 16 + h] : 0.f); } } }
}
__device__ __forceinline__ void p0_ssm_fill(Frame& F, const Args& args, int g, int q) {
    P0_SSM_LDS()
    bf16* W2 = (bf16*)(ws + WS_W2); bf16* KW = (bf16*)(ws + WS_KW);
    for (int task = tid; task < 32 * 32; task += 512) { const int n = 32 * q + (task >> 5), k8 = task & 31, s = k8 >> 1; float v[8];
#pragma unroll
        for (int e = 0; e < 8; ++e) { const int h2 = 8 * (k8 & 1) + e; float val = 0.f;
            if (n < 128) { const int p = n & 63; const float wr = pwr[(15 - s) * 64 + p], wi = pwi[(15 - s) * 64 + p], br = bbr[p * 16 + h2], bi = bbi[p * 16 + h2];
                val = (n >> 6) ? (wr * bi + wi * br) : (wr * br - wi * bi); }
            v[e] = val; }
        v4u o; o.x = pk2(v[0], v[1]); o.y = pk2(v[2], v[3]); o.z = pk2(v[4], v[5]); o.w = pk2(v[6], v[7]);
        *(GAS v4u*)(W2 + (size_t)(g * 256 + n) * 256 + 8 * k8) = o; }
    for (int task = tid; task < 32 * 48; task += 512) { const int n = 32 * q + task / 48, k8 = task % 48, t = n >> 4, h = n & 15; float v[8];
#pragma unroll
        for (int e = 0; e < 8; ++e) { float val;
            if (k8 < 32) { const int s = k8 >> 1, h2 = 8 * (k8 & 1) + e; val = (s <= t) ? klag[((t - s) * 16 + h) * 16 + h2] : 0.f; }
            else { const int kk = 8 * (k8 - 32) + e, part = kk >> 6, p = kk & 63; const float wr = pwr[(t + 1) * 64 + p], wi = pwi[(t + 1) * 64 + p], cr = cre[h * 64 + p], ci = cim[h * 64 + p];
                val = part ? -(cr * wi + ci * wr) : (cr * wr - ci * wi); }
            v[e] = val; }
        v4u o; o.x = pk2(v[0], v[1]); o.y = pk2(v[2], v[3]); o.z = pk2(v[4], v[5]); o.w = pk2(v[6], v[7]);
        *(GAS v4u*)(KW + (size_t)(g * 256 + n) * ALD + 8 * k8) = o; }
}
__device__ __forceinline__ void p0_attn_tables(Frame& F, const Args& args) {
    LAS float* L = (LAS float*)(F.lds + RING_OFF); float* tab = (float*)(args.ws + WS_TAB); const int tid = F.tid;
    if (tid < 64) {
        float s1 = args.in[6][tid] * args.in[7][tid], s2 = args.in[8][tid] * args.in[9][tid];
        float mq = fabsf(args.in[4][tid]), mk = fabsf(args.in[5][tid]), mt = fmaxf(fabsf(args.in[11][tid]), fabsf(args.in[11][64 + tid]));
#pragma unroll
        for (int o = 1; o < 64; o <<= 1) { s1 += __shfl_xor(s1, o); s2 += __shfl_xor(s2, o); mq = fmaxf(mq, __shfl_xor(mq, o)); mk = fmaxf(mk, __shfl_xor(mk, o)); mt = fmaxf(mt, __shfl_xor(mt, o)); }
        const float m0 = 8.0f * mq * mk + mt;
        if (tid == 0) { tab[TB_LAM] = expf(s1) - expf(s2) + LAM_INIT; tab[TB_M0] = m0; L[0] = m0; }
    }
    __syncthreads();
    const float m0 = L[0];
    if (tid < 4) tab[TB_CFAR + tid] = (args.in[11][15 * 4 + tid] - m0) * LOG2E;
    if (tid < 64) { tab[TB_QG + tid] = args.in[4][tid] * 0.125f * LOG2E; tab[TB_KG + tid] = args.in[5][tid]; }
    for (int i = tid; i < 1024; i += 512) { const int h = i >> 8, idx = i & 255; tab[TB_BIASL + i] = (args.in[11][rel_bucket(idx - 192) * 4 + h] - m0) * LOG2E; }
    __syncthreads();
}
__device__ __forceinline__ void p0_prologue(Frame& F, const Args& args) {
    unsigned char* ws = args.ws;
    const int gw = F.vcu * NWAVES + F.wave, NGW = F.G * NWAVES;
    const int g = F.vcu >> 3, q = F.vcu & 7; const bool ssm = F.vcu < 8 * NG;
    bf16* XN = (bf16*)(ws + WS_XN); const float* x = args.in[0]; const float* gain = args.in[1];
    XnBatch B0, B1;
    int m = gw;
#define XN_HAVE(mm) ((mm) + 3 * NGW < MTOK)
    const bool h0 = XN_HAVE(m), h1 = XN_HAVE(m + 4 * NGW), h2 = XN_HAVE(m + 8 * NGW), h3 = XN_HAVE(m + 12 * NGW);
    if (h0) xn_load(B0, F.lane, x, m, NGW);
    if (h1) xn_load(B1, F.lane, x, m + 4 * NGW, NGW);
    if (ssm) p0_ssm_step1(F, args, g, q);
    __syncthreads();
    if (h0) xn_finish(B0, F.lane, gain, XN, m, NGW);
    if (h2) xn_load(B0, F.lane, x, m + 8 * NGW, NGW);
    if (ssm) p0_ssm_klag(F, args, g, q);
    __syncthreads();
    if (h1) xn_finish(B1, F.lane, gain, XN, m + 4 * NGW, NGW);
    if (h3) xn_load(B1, F.lane, x, m + 12 * NGW, NGW);
    if (ssm) p0_ssm_fill(F, args, g, q);
    __syncthreads();
    if (F.vcu == F.G - 1) p0_attn_tables(F, args);
    if (h2) xn_finish(B0, F.lane, gain, XN, m + 8 * NGW, NGW);
    LAS float* scr = (LAS float*)(F.lds + RING_OFF + F.wave * 16384);
    constexpr int I_IN = (DM / 64) * (NCOL / 32), I_GLU = (SW / 64) * (SW / 32), I_PA = (AW / 64) * (DM / 32), I_PS = (SW / 64) * (DM / 32), I_WO = (DM / 64) * (DM / 32);
    constexpr int NITEMS = I_IN + I_GLU + I_PA + I_PS + I_WO;
    for (int it = gw; it < NITEMS; it += NGW) {
        int r = it;
        if (r < I_IN) { p0_transpose_item<true>(args.in[2], DM, NCOL, (bf16*)(ws + WS_WIN), DM, scr, r, F.lane); }
        else if ((r -= I_IN) < I_GLU) { p0_transpose_item<false>(args.in[20], SW, SW, (bf16*)(ws + WS_GLUW), SW, scr, r, F.lane); }
        else if ((r -= I_GLU) < I_PA) { p0_transpose_item<false>(args.in[22], AW, DM, (bf16*)(ws + WS_PAS), 1024, scr, r, F.lane); }
        else if ((r -= I_PA) < I_PS) { p0_transpose_item<false>(args.in[23], SW, DM, (bf16*)(ws + WS_PAS) + 512, 1024, scr, r, F.lane); }
        else { r -= I_PS; p0_transpose_item<false>(args.in[24], DM, DM, (bf16*)(ws + WS_WOUT), DM, scr, r, F.lane); }
    }
    if (h3) xn_finish(B1, F.lane, gain, XN, m + 12 * NGW, NGW);
    m += 4 * NGW * ((h0 ? 1 : 0) + (h1 ? 1 : 0) + (h2 ? 1 : 0) + (h3 ? 1 : 0));
    while (XN_HAVE(m)) { xn_load(B0, F.lane, x, m, NGW); xn_finish(B0, F.lane, gain, XN, m, NGW); m += 4 * NGW; }
    for (; m < MTOK; m += NGW) { const GAS f32x4* xr = (const GAS f32x4*)(x + (size_t)m * DM) + F.lane; f32x4 v[4]; float s2 = 0.f;
#pragma unroll
        for (int j = 0; j < 4; ++j) { v[j] = xr[64 * j]; s2 += (v[j].x * v[j].x + v[j].y * v[j].y) + (v[j].z * v[j].z + v[j].w * v[j].w); }
        const float rstd = 1.0f / sqrtf(wave_sum(s2) * (1.f / DM) + 1e-6f); const GAS f32x4* gr = (const GAS f32x4*)gain + F.lane; GAS unsigned long long* o8 = (GAS unsigned long long*)(XN + (size_t)m * DM) + F.lane;
#pragma unroll
        for (int j = 0; j < 4; ++j) { const f32x4 gg = gr[64 * j]; o8[64 * j] = (unsigned long long)pk2(v[j].x * rstd * gg.x, v[j].y * rstd * gg.y) | ((unsigned long long)pk2(v[j].z * rstd * gg.z, v[j].w * rstd * gg.w) << 32); } }
#undef XN_HAVE
}
namespace att {
typedef float f32x16 __attribute__((ext_vector_type(16)));
typedef short s16x4 __attribute__((ext_vector_type(4)));
typedef short v4i16_t __attribute__((ext_vector_type(4)));
typedef short bf16x8 __attribute__((ext_vector_type(8)));
typedef unsigned u32x4 __attribute__((ext_vector_type(4)));
typedef float f32x2_t __attribute__((ext_vector_type(2))); typedef __bf16 bf16x2_t __attribute__((ext_vector_type(2)));
typedef __attribute__((address_space(3))) const char* lds_cptr;
typedef __attribute__((address_space(3))) char* lds_ptr;
constexpr int SLOT = 16384, NSLOT = 3;
constexpr int L_K = 0, L_V = NSLOT * SLOT, L_X3 = 2 * NSLOT * SLOT;
__device__ __forceinline__ int x_off(int qg) { return qg == 0 ? 2 * SLOT : qg == 1 ? L_V + SLOT : qg == 2 ? L_V + 2 * SLOT : L_X3; }
constexpr int L_LS = LDS_EXTRA_OFF, L_BIAS = LDS_EXTRA_OFF + 1024;
__device__ __forceinline__ int crow(int r, int hi) { return (r & 3) + 8 * (r >> 2) + 4 * hi; }
__device__ __forceinline__ unsigned cvtpk(float lo, float hi) { f32x2_t v = {lo, hi}; bf16x2_t b = __builtin_convertvector(v, bf16x2_t); return __builtin_bit_cast(unsigned, b); }
__device__ __forceinline__ s16x4 vtr(lds_cptr p) { return __builtin_bit_cast(s16x4, __builtin_amdgcn_ds_read_tr16_b64_v4i16((__attribute__((address_space(3))) v4i16_t*)p)); }
__device__ __forceinline__ void glds16(const void* gsrc, unsigned lds_dst) { unsigned keep;
    asm volatile("s_mov_b32 %0, m0\n\ts_mov_b32 m0, %2\n\ts_nop 0\n\tglobal_load_lds_dwordx4 %1, off\n\ts_mov_b32 m0, %0" : "=&s"(keep) : "v"(gsrc), "s"(lds_dst) : "memory"); }
#define ATT_WAITV(N) asm volatile("s_waitcnt vmcnt(" #N ")" ::: "memory")
#define ATT_BAR() do { asm volatile("s_waitcnt lgkmcnt(0)" ::: "memory"); __builtin_amdgcn_s_barrier(); asm volatile("" ::: "memory"); } while (0)

struct UnitId { int b, h, qb; };
struct UnitSrc { const bf16* ksrc[2]; const bf16* vsrc[2]; const bf16* qp; };
__device__ __forceinline__ UnitSrc unit_src(const UnitId u, unsigned char* ws, int wid, int lane) {
    const bf16* Qg = (const bf16*)(ws + WS_Q) + (size_t)u.b * QKB; const bf16* Kg = Qg + QKK; const bf16* Vg = (const bf16*)(ws + WS_V);
    const int qg = wid & 3, s = wid >> 2, r32 = lane & 31; UnitSrc S;
#pragma unroll
    for (int i = 0; i < 2; ++i) { const int pi = 2 * wid + i, ss = pi >> 3, c = pi & 7, db = pi >> 2, ks = pi & 3;
        S.ksrc[i] = Kg + (size_t)(u.h * 2 + ss) * 64 * 4096 + c * 512 + lane * 8;
        S.vsrc[i] = Vg + ((size_t)(u.b * 4 + u.h) * SEQ + 16 * ks + (lane >> 2)) * VD + 32 * db + (lane & 3) * 8; }
    S.qp = Qg + ((size_t)(u.h * 2 + s) * 64 + (2 * u.qb + (qg >> 1))) * 4096 + (32 * (qg & 1) + r32) * 8;
    return S;
}
__device__ __forceinline__ int attn_unit(const UnitId cu, bool first, bool has_next_s, const UnitId nx_s, unsigned* qcnt, unsigned char* ws, LAS unsigned char* lds, bf16x8 (&qf)[4]) {
    const int b = cu.b, h = cu.h, qb = cu.qb;
    int tid_ = threadIdx.x; asm volatile("" : "+v"(tid_));
    const int tid = tid_, lane = tid & 63, r32 = lane & 31, hi = lane >> 5;
    const int wid = __builtin_amdgcn_readfirstlane(tid >> 6), qg = wid & 3, s = wid >> 2;
    const float* tab = (const float*)(ws + WS_TAB);
#ifdef PROBE_ATT
    const unsigned long long tent_ = __builtin_amdgcn_s_memrealtime();
#endif
    const int NT = 2 * qb + 2;
    const int NTw = 2 * qb + (qg >> 1) + 1;
    const int tq0 = 128 * qb + 32 * qg;
    const UnitSrc US = unit_src(cu, ws, wid, lane);
    int kdst[2], vdst[2];
#pragma unroll
    for (int i = 0; i < 2; ++i) { const int pi = 2 * wid + i; kdst[i] = L_K + (pi >> 3) * 8192 + (pi & 7) * 1024; vdst[i] = L_V + ((pi >> 2) * 4 + (pi & 3)) * 1024; }
    const unsigned lds0 = (unsigned)(size_t)lds;
#define ATT_DMAK_(src, t, slot) do { _Pragma("unroll") for (int i_ = 0; i_ < 2; ++i_) \
        glds16((src).ksrc[i_] + (size_t)(t) * 4096, (unsigned)__builtin_amdgcn_readfirstlane((int)(lds0 + kdst[i_] + (slot) * SLOT))); } while (0)
#define ATT_DMAV_(src, t, slot) do { _Pragma("unroll") for (int i_ = 0; i_ < 2; ++i_) \
        glds16((src).vsrc[i_] + (size_t)(t) * 64 * VD, (unsigned)__builtin_amdgcn_readfirstlane((int)(lds0 + vdst[i_] + (slot) * SLOT))); } while (0)
#define ATT_DMAK(t, slot) ATT_DMAK_(US, t, slot)
#define ATT_DMAV(t, slot) ATT_DMAV_(US, t, slot)
#define ATT_QLOAD(src) do { _Pragma("unroll") for (int d0 = 0; d0 < 4; ++d0) qf[d0] = *(const bf16x8*)((src).qp + (2 * d0 + hi) * 512); } while (0)
    if (first) {
        ATT_DMAK(0, 0); ATT_DMAK(1, 1); ATT_DMAV(0, 0);
        ATT_QLOAD(US);
        if (tid < 256) ((LAS float*)(lds + L_BIAS))[tid] = tab[TB_BIASL + h * 256 + tid] - tab[TB_CFAR + h];
    }
    const float cfar = tab[TB_CFAR + h], lam = tab[TB_LAM];
    asm volatile("" :: "v"(cfar), "v"(lam), "v"(qf[0]), "v"(qf[1]), "v"(qf[2]), "v"(qf[3]));
    f32x16 o[4];
#pragma unroll
    for (int d = 0; d < 4; ++d) o[d] = (f32x16){0.f, 0.f, 0.f, 0.f, 0.f, 0.f, 0.f, 0.f, 0.f, 0.f, 0.f, 0.f, 0.f, 0.f, 0.f, 0.f};
    f32x16 lacc = (f32x16){0.f, 0.f, 0.f, 0.f, 0.f, 0.f, 0.f, 0.f, 0.f, 0.f, 0.f, 0.f, 0.f, 0.f, 0.f, 0.f};
    const bf16x8 ones = (bf16x8){0x3F80, 0x3F80, 0x3F80, 0x3F80, 0x3F80, 0x3F80, 0x3F80, 0x3F80};
    const lds_cptr kbase = (lds_cptr)lds + L_K + s * 8192 + hi * 1024 + r32 * 16;
    const lds_cptr vbase = (lds_cptr)lds + L_V + ((lane >> 4) & 1) * 32 + (lane & 3) * 8 + (4 * hi + ((lane & 15) >> 2)) * 64;
    f32x16 cfv;
#pragma unroll
    for (int r = 0; r < 16; ++r) cfv[r] = cfar;
    asm volatile("" : "+v"(cfv));
    u32x4 pw[4];
    f32x16 p0, p1;
    int slot = 0, pslot = 0;
#define ATT_SB() __builtin_amdgcn_sched_barrier(0)
#define ATT_VF(i) ({ const s16x4 lo_ = vtr(vp + (i) * 1024), hh_ = vtr(vp + (i) * 1024 + 512); (bf16x8){lo_[0], lo_[1], lo_[2], lo_[3], hh_[0], hh_[1], hh_[2], hh_[3]}; })
#define ATT_KLOAD() do { const lds_cptr kp = kbase + slot * SLOT; \
        _Pragma("unroll") for (int d0 = 0; d0 < 4; ++d0) { kf[2 * d0] = *(const __attribute__((address_space(3))) bf16x8*)(kp + d0 * 2048); \
                                                         kf[2 * d0 + 1] = *(const __attribute__((address_space(3))) bf16x8*)(kp + d0 * 2048 + 512); } } while (0)
#define ATT_QK(cv_) do { \
        p0 = __builtin_amdgcn_mfma_f32_32x32x16_bf16(kf[0], qf[0], (cv_), 0, 0, 0); \
        p1 = __builtin_amdgcn_mfma_f32_32x32x16_bf16(kf[1], qf[0], (cv_), 0, 0, 0); \
        _Pragma("unroll") for (int d0 = 1; d0 < 4; ++d0) { \
            p0 = __builtin_amdgcn_mfma_f32_32x32x16_bf16(kf[2 * d0], qf[d0], p0, 0, 0, 0); \
            p1 = __builtin_amdgcn_mfma_f32_32x32x16_bf16(kf[2 * d0 + 1], qf[d0], p1, 0, 0, 0); } } while (0)
#define ATT_NEARBIAS(t_) do { const LAS float* bt = (const LAS float*)(lds + L_BIAS) + (64 * (t_) - tq0 - r32 + 192); \
        _Pragma("unroll") for (int r = 0; r < 16; ++r) { p0[r] += bt[crow(r, hi)]; p1[r] += bt[crow(r, hi) + 32]; } } while (0)
#define ATT_PACK() do { _Pragma("unroll") for (int j = 0; j < 4; ++j) { pw[0][j] = cvtpk(p0[2 * j], p0[2 * j + 1]); pw[1][j] = cvtpk(p0[8 + 2 * j], p0[8 + 2 * j + 1]); \
                                          pw[2][j] = cvtpk(p1[2 * j], p1[2 * j + 1]); pw[3][j] = cvtpk(p1[8 + 2 * j], p1[8 + 2 * j + 1]); } } while (0)
#ifdef PROBE_ATT
    unsigned long long tseg_[7]; tseg_[1] = __builtin_amdgcn_s_memrealtime();
#define ATT_TS(i) do { tseg_[i] = __builtin_amdgcn_s_memrealtime(); } while (0)
#else
#define ATT_TS(i) do {} while (0)
#endif
    volatile LAS unsigned* qw = (volatile LAS unsigned*)(lds + MISC_OFF) + 13;
    for (int t = 0; t <= NT; ++t) {
        if (qcnt && t == NT - 1 && tid == 0) *qw = __hip_atomic_fetch_add(qcnt, 1u, __ATOMIC_RELAXED, __HIP_MEMORY_SCOPE_AGENT);
        if (t == 0 || t + 1 < NT) ATT_WAITV(4); else if (t < NT) ATT_WAITV(2); else ATT_WAITV(0);
        ATT_BAR();
        if (t + 2 < NT) { const int s2 = (slot + 2 >= NSLOT) ? slot + 2 - NSLOT : slot + 2; ATT_DMAK(t + 2, s2); }
        if (t + 1 < NT) { const int s1 = (slot + 1 >= NSLOT) ? slot + 1 - NSLOT : slot + 1; ATT_DMAV(t + 1, s1); }
        const lds_cptr vp = vbase + pslot * SLOT;
        if (t >= 1 && t < NTw) {
            const bool nearT = (t + 3 >= NTw);
            bf16x8 kf[8], vfr[4];
            ATT_KLOAD();
            vfr[0] = ATT_VF(0); vfr[1] = ATT_VF(1); vfr[2] = ATT_VF(2);
            ATT_SB();
            ATT_QK(cfv);
            if (nearT) ATT_NEARBIAS(t);
            ATT_SB();
#pragma unroll
            for (int i = 0; i < 16; ++i) {
                o[i >> 2] = __builtin_amdgcn_mfma_f32_32x32x16_bf16(__builtin_bit_cast(bf16x8, pw[i & 3]), vfr[i & 3], o[i >> 2], 0, 0, 0);
                if (i < 4) lacc = __builtin_amdgcn_mfma_f32_32x32x16_bf16(__builtin_bit_cast(bf16x8, pw[i]), ones, lacc, 0, 0, 0);
                if (i + 3 < 16) vfr[(i + 3) & 3] = ATT_VF(i + 3);
                p0[i] = __builtin_amdgcn_exp2f(p0[i]); p1[i] = __builtin_amdgcn_exp2f(p1[i]);
                ATT_SB();
            }
            ATT_PACK();
        } else if (t == 0) {
            const bool nearT = (t + 3 >= NTw);
            bf16x8 kf[8]; ATT_KLOAD();
            ATT_QK(cfv);
            if (nearT) ATT_NEARBIAS(t);
#pragma unroll
            for (int r = 0; r < 16; ++r) { p0[r] = __builtin_amdgcn_exp2f(p0[r]); p1[r] = __builtin_amdgcn_exp2f(p1[r]); }
            ATT_PACK();
        } else if (t == NTw) {
#pragma unroll
            for (int i = 0; i < 16; ++i) { const bf16x8 vf = ATT_VF(i);
                o[i >> 2] = __builtin_amdgcn_mfma_f32_32x32x16_bf16(__builtin_bit_cast(bf16x8, pw[i & 3]), vf, o[i >> 2], 0, 0, 0);
                if (i < 4) lacc = __builtin_amdgcn_mfma_f32_32x32x16_bf16(__builtin_bit_cast(bf16x8, pw[i]), ones, lacc, 0, 0, 0); }
        }
        pslot = slot; slot = (slot + 1 == NSLOT) ? 0 : slot + 1;
    }
#undef ATT_SB
#undef ATT_VF
#undef ATT_QK
#undef ATT_KLOAD
#undef ATT_NEARBIAS
#undef ATT_PACK
    ATT_TS(2);
    ATT_BAR();
    ATT_TS(3);
    int nq = 64; bool has_next = has_next_s; UnitId nx = nx_s;
    if (qcnt) { nq = (int)*qw; has_next = nq < 32; nx.b = b; nx.h = h; nx.qb = has_next ? 31 - nq : qb; }
    const int row = lane >> 2, quar = lane & 3;
    const int rbase = (s == 0) ? 16 : 0;
    const size_t tok = (size_t)b * SEQ + tq0 + rbase + row;
    u32x4 gav[4];
    { const bf16* ga = (const bf16*)(ws + WS_GA) + tok * 512 + h * 128 + quar * 32;
#pragma unroll
      for (int j = 0; j < 4; ++j) gav[j] = *(const u32x4*)(ga + j * 8); }
    if (has_next) {
        const UnitSrc NS = unit_src(nx, ws, wid, lane);
        ATT_DMAK_(NS, 0, 0); ATT_DMAK_(NS, 1, 1); ATT_DMAV_(NS, 0, 0);
        if (nx.h != h && tid < 256) ((LAS float*)(lds + L_BIAS))[tid] = tab[TB_BIASL + nx.h * 256 + tid] - tab[TB_CFAR + nx.h];
    }
    const float sc = (s == 1) ? lam : 1.0f;
#pragma unroll
    for (int r = 0; r < 16; ++r) { const float f = sc * __builtin_amdgcn_rcpf(lacc[r]);
#pragma unroll
        for (int db = 0; db < 4; ++db) o[db][r] *= f; }
    LAS float* XW = (LAS float*)(lds + x_off(qg)) + (s == 0 ? 0 : 2048);
    LAS float* XR = (LAS float*)(lds + x_off(qg)) + (s == 0 ? 2048 : 0);
    if (s == 0) {
#pragma unroll
        for (int db = 0; db < 4; ++db)
#pragma unroll
            for (int r = 0; r < 8; ++r) XW[(db * 8 + r) * 64 + lane] = o[db][r];
    } else {
#pragma unroll
        for (int db = 0; db < 4; ++db)
#pragma unroll
            for (int r = 0; r < 8; ++r) XW[(db * 8 + r) * 64 + lane] = o[db][8 + r];
    }
    ATT_BAR();
    ATT_TS(4);
    float v[4][8];
    if (s == 0) {
#pragma unroll
        for (int db = 0; db < 4; ++db)
#pragma unroll
            for (int r = 0; r < 8; ++r) v[db][r] = o[db][8 + r] - XR[(db * 8 + r) * 64 + lane];
    } else {
#pragma unroll
        for (int db = 0; db < 4; ++db)
#pragma unroll
            for (int r = 0; r < 8; ++r) v[db][r] = XR[(db * 8 + r) * 64 + lane] - o[db][r];
    }
    asm volatile("s_waitcnt lgkmcnt(0)" ::: "memory");
    LAS bf16* stg = (LAS bf16*)XR;
#pragma unroll
    for (int db = 0; db < 4; ++db)
#pragma unroll
        for (int r = 0; r < 8; ++r) { const float x_ = v[db][r]; stg[crow(r, hi) * 128 + 32 * db + r32] = (bf16)(cvtpk(x_, x_) & 0xffffu); }
    asm volatile("s_waitcnt lgkmcnt(0)" ::: "memory");
    { u32x4 w[4]; float ss = 0.f;
#pragma unroll
      for (int j = 0; j < 4; ++j) { w[j] = *(const LAS u32x4*)(stg + row * 128 + quar * 32 + j * 8);
          pg8::f32x4 a, c; pg8::unpack8(w[j], a, c); ss += (a[0] * a[0] + a[1] * a[1]) + (a[2] * a[2] + a[3] * a[3]) + (c[0] * c[0] + c[1] * c[1]) + (c[2] * c[2] + c[3] * c[3]); }
      ss += __shfl_xor(ss, 1); ss += __shfl_xor(ss, 2);
      const float rstd = rsqrtf(ss * (1.0f / 128.0f) + 1e-6f);
      bf16* oa = (bf16*)(ws + WS_OAS) + tok * 1024 + h * 128 + quar * 32;
#pragma unroll
      for (int j = 0; j < 4; ++j) { pg8::f32x4 a, c, g0, g1; pg8::unpack8(w[j], a, c); pg8::unpack8(gav[j], g0, g1);
          *(u32x4*)(oa + j * 8) = pg8::pack8(a * rstd * g0, c * rstd * g1); } }
    ATT_TS(5);
    if (has_next) { const UnitSrc NS = unit_src(nx, ws, wid, lane); ATT_QLOAD(NS); }
    ATT_BAR();
    ATT_TS(6);
#ifdef PROBE_ATT
    tseg_[0] = tent_;
    if (tid == 0) { volatile LAS unsigned* mm = (volatile LAS unsigned*)(lds + MISC_OFF); const unsigned long long d_ = tseg_[PROBE_ATT + 1] - tseg_[PROBE_ATT]; const unsigned long long acc_ = (((unsigned long long)mm[25] << 32) | mm[24]) + d_; mm[24] = (unsigned)acc_; mm[25] = (unsigned)(acc_ >> 32); }
#endif
    return nq;
#undef ATT_DMAK_
#undef ATT_DMAV_
#undef ATT_QLOAD
#undef ATT_DMAK
#undef ATT_DMAV
}
__device__ __forceinline__ void phase_attn_body(int vcu, int G, unsigned char* ws, LAS unsigned char* lds) {
    bf16x8 qf[4];
#if 1
    if (__builtin_amdgcn_readfirstlane(threadIdx.x) >= 256) __builtin_amdgcn_s_setprio(1);
#endif
    if (G == 256) {
        const int bh = vcu >> 3, s8 = vcu & 7;
#define ATT_QB(i) ((i) == 0 ? 31 - s8 : (i) == 1 ? 16 + s8 : (i) == 2 ? 15 - s8 : s8)
#pragma unroll 1
        for (int i = 0; i < 4; ++i) { const UnitId c{bh >> 2, bh & 3, ATT_QB(i)}; const UnitId n{bh >> 2, bh & 3, ATT_QB(i < 3 ? i + 1 : 3)}; (void)attn_unit(c, i == 0, i < 3, n, nullptr, ws, lds, qf); }
#undef ATT_QB
    } else {
        bool first = true;
#pragma unroll 1
        for (int uu = vcu; uu < BATCH * NH * 32; uu += G) { const UnitId c{uu >> 7, (uu >> 5) & 3, 31 - (uu & 31)}; const int nn = uu + G; const bool hn = nn < BATCH * NH * 32;
            const UnitId n{hn ? nn >> 7 : c.b, hn ? (nn >> 5) & 3 : c.h, hn ? 31 - (nn & 31) : c.qb}; (void)attn_unit(c, first, hn, n, nullptr, ws, lds, qf); first = false; }
    }
#if 1
    __builtin_amdgcn_s_setprio(0);
#endif
}
#undef ATT_WAITV
#undef ATT_BAR
}
#ifndef PG8_SP2
#define PG8_SP2 true
#endif
#ifndef PG8_ALIGN
#define PG8_ALIGN true
#endif
#ifndef ALIGN_P1
#define ALIGN_P1 true
#endif
#ifndef ALIGN_P5
#define ALIGN_P5 true
#endif
#ifndef ALIGN_P6
#define ALIGN_P6 true
#endif
__device__ __forceinline__ void phase_attn(Frame& F, const Args& args, char*) { att::phase_attn_body(F.vcu, F.G, args.ws, F.lds); }
__device__ __forceinline__ void phase_inproj(Frame& F, const Args& args) {
    unsigned char* ws = args.ws;
    pg8::Gemm g{(const bf16*)(ws + WS_XN), (const bf16*)(ws + WS_WIN), MTOK, NCOL, DM, DM, DM};
    pg8::StaticOrder S; S.init(MTOK, NCOL, F.G, (int)blockIdx.x);
    pg8::EpiInProj E{ws, args.in[3], args.in[10]};
    pg8::gemm_phase<pg8::EpiInProj, pg8::StaticOrder, ALIGN_P1, PG8_SP2>(F.lds + RING_OFF, g, S, E);
}
__device__ __forceinline__ void phase_ssm(Frame& F, const Args& args) {
    unsigned char* ws = args.ws;
    { const int L = F.vcu; if (L < BATCH * NG) {
        const int gg = L & 31, b = L >> 5, bg = b * NG + gg;
        pg8::OneUnit S{{bg, gg}};
        { pg8::Gemm g{(const bf16*)(ws + WS_U), (const bf16*)(ws + WS_W2), BATCH * NG * NCH, NG * 256, 256, ALD, 256};
          pg8::EpiEnd E{};
          pg8::gemm_phase<pg8::EpiEnd, pg8::OneUnit, false, PG8_SP2>(F.lds + RING_OFF, g, S, E); }
        LDS_WAIT(); __syncthreads();
        {
            const int p = F.lane, w = F.wave; const float* tab = (const float*)(ws + WS_TAB);
            const float ar = tab[TB_LB16 + (gg * 64 + p) * 2], ai = tab[TB_LB16 + (gg * 64 + p) * 2 + 1];
            const LAS float* END = (const LAS float*)(F.lds + RING_OFF);
            LAS float* EX = (LAS float*)(F.lds + LDS_EXTRA_OFF);
            float pr[32], pi[32]; float cr = 0.f, ci = 0.f;
#pragma unroll
            for (int j = 0; j < 32; ++j) { const int k = 32 * w + j; const float er = END[pg8::end_lds_idx(k, p)], ei = END[pg8::end_lds_idx(k, 64 + p)];
                pr[j] = cr; pi[j] = ci; const float nr = ar * cr - ai * ci + er, ni = ar * ci + ai * cr + ei; cr = nr; ci = ni; }
            EX[(w * 2 + 0) * 64 + p] = cr; EX[(w * 2 + 1) * 64 + p] = ci;
            float qr = ar, qi = ai;
#pragma unroll
            for (int i = 0; i < 5; ++i) { const float nr = qr * qr - qi * qi, ni = 2.f * qr * qi; qr = nr; qi = ni; }
            LDS_WAIT(); __syncthreads();
            float sr = 0.f, si = 0.f;
            for (int v = 0; v < w; ++v) { const float er = EX[(v * 2 + 0) * 64 + p], ei = EX[(v * 2 + 1) * 64 + p]; const float nr = qr * sr - qi * si + er, ni = qr * si + qi * sr + ei; sr = nr; si = ni; }
            bf16* A = (bf16*)(ws + WS_U) + ((size_t)bg * NCH + 32 * w) * ALD + 256;
            float zr = sr, zi = si;
#pragma unroll
            for (int j = 0; j < 32; ++j) { A[j * ALD + p] = (bf16)f2bf(pr[j] + zr); A[j * ALD + 64 + p] = (bf16)f2bf(pi[j] + zi);
                const float nr = ar * zr - ai * zi, ni = ar * zi + ai * zr; zr = nr; zi = ni; }
        }
        VM_WAIT(); LDS_WAIT(); __syncthreads();
        { pg8::Gemm g{(const bf16*)(ws + WS_U), (const bf16*)(ws + WS_KW), BATCH * NG * NCH, NG * 256, ALD, ALD, ALD};
          pg8::EpiY E{(bf16*)(ws + WS_G)};
          pg8::gemm_phase<pg8::EpiY, pg8::OneUnit, false, PG8_SP2>(F.lds + RING_OFF, g, S, E); }
    } }
}
__device__ __forceinline__ void phase_glu_t1(Frame& F, const Args& args) {
    unsigned char* ws = args.ws;
    pg8::Gemm g{(const bf16*)(ws + WS_G), (const bf16*)(ws + WS_GLUW), MTOK, SW, SW, SW, SW};
    pg8::StaticOrder S; S.init(MTOK, SW, F.G, (int)blockIdx.x);
    pg8::EpiGlu E{(const bf16*)(ws + WS_G), (const bf16*)(ws + WS_GS), (bf16*)(ws + WS_OAS), args.in[21]};
    pg8::gemm_phase<pg8::EpiGlu, pg8::StaticOrder, PG8_ALIGN, PG8_SP2>(F.lds + RING_OFF, g, S, E);
}
__device__ __forceinline__ void phase_merge(Frame& F, const Args& args) {
    unsigned char* ws = args.ws;
    pg8::Gemm g{(const bf16*)(ws + WS_OAS), (const bf16*)(ws + WS_PAS), MTOK, DM, DM, DM, DM};
    pg8::StaticOrder S; S.init(MTOK, DM, F.G, (int)blockIdx.x);
    pg8::EpiMerge E{(const bf16*)(ws + WS_MG), (bf16*)(ws + WS_MRG)};
    pg8::gemm_phase<pg8::EpiMerge, pg8::StaticOrder, ALIGN_P5, PG8_SP2, 512>(F.lds + RING_OFF, g, S, E);
}
__device__ __forceinline__ void phase_out(Frame& F, const Args& args) {
    unsigned char* ws = args.ws;
    pg8::Gemm g{(const bf16*)(ws + WS_MRG), (const bf16*)(ws + WS_WOUT), MTOK, DM, DM, DM, DM};
    pg8::StaticOrder S; S.init(MTOK, DM, F.G, (int)blockIdx.x);
    pg8::EpiOut E{args.in[0], args.out};
    pg8::gemm_phase<pg8::EpiOut, pg8::StaticOrder, ALIGN_P6, PG8_SP2>(F.lds + RING_OFF, g, S, E);
}
#if USE_NAIVE
struct NArgs { const float* in[25]; float* out; unsigned char* ws; };
__device__ __forceinline__ void st_bf(bf16* p, size_t i, float v) { p[i] = (bf16)f2bf(v); }

template <int MODE> __global__ void __launch_bounds__(256) nk_gemm(NArgs a) {
    __shared__ float As[16][65], Bs[16][65], red[64][17];
    unsigned char* ws = a.ws; const float* tab = (const float*)(ws + WS_TAB);
    const bf16* A; const bf16* Bt; int K, lda;
    if (MODE == 1) { A = (const bf16*)(ws + WS_XN); Bt = (const bf16*)(ws + WS_WIN); K = 1024; lda = 1024; }
    else if (MODE == 3) { A = (const bf16*)(ws + WS_G); Bt = (const bf16*)(ws + WS_GLUW); K = 512; lda = 512; }
    else if (MODE == 4) { A = (const bf16*)(ws + WS_OA); Bt = (const bf16*)(ws + WS_PA); K = 512; lda = 512; }
    else if (MODE == 5) { A = (const bf16*)(ws + WS_OS); Bt = (const bf16*)(ws + WS_PS); K = 512; lda = 512; }
    else { A = (const bf16*)(ws + WS_T1); Bt = (const bf16*)(ws + WS_WOUT); K = 1024; lda = 1024; }
    const int tid = threadIdx.x, ty = tid >> 4, tx = tid & 15, m0 = blockIdx.y * 64, n0 = blockIdx.x * 64;
    float acc[4][4] = {};
    for (int k0 = 0; k0 < K; k0 += 16) {
        for (int i = tid; i < 1024; i += 256) { const int r = i >> 4, kk = i & 15;
            As[kk][r] = bf2f(A[(size_t)(m0 + r) * lda + k0 + kk]);
            const int n = n0 + r; const int br = (MODE == 1) ? rowmap_in(n) : n;
            Bs[kk][r] = bf2f(Bt[(size_t)br * K + k0 + kk]); }
        __syncthreads();
#pragma unroll
        for (int kk = 0; kk < 16; ++kk) { float av[4], bv[4];
#pragma unroll
            for (int i = 0; i < 4; ++i) { av[i] = As[kk][ty * 4 + i]; bv[i] = Bs[kk][tx * 4 + i]; }
#pragma unroll
            for (int i = 0; i < 4; ++i)
#pragma unroll
                for (int j = 0; j < 4; ++j) acc[i][j] += av[i] * bv[j]; }
        __syncthreads();
    }
    if (MODE == 1) {
        const int typ = n0 < 512 ? 0 : n0 < 1024 ? 1 : n0 < 1536 ? 2 : n0 < 2048 ? 3 : n0 < 2560 ? 4 : n0 < 3072 ? 5 : 6;
        float rstd[4] = {1.f, 1.f, 1.f, 1.f};
        if (typ <= 1) {
            for (int i = 0; i < 4; ++i) { float s = 0.f; for (int j = 0; j < 4; ++j) s += acc[i][j] * acc[i][j]; red[ty * 4 + i][tx] = s; }
            __syncthreads();
            for (int i = 0; i < 4; ++i) { float s = 0.f; for (int j = 0; j < 16; ++j) s += red[ty * 4 + i][j]; rstd[i] = rsqrtf(s * (1.0f / 64.0f) + 1e-6f); }
        }
        for (int i = 0; i < 4; ++i) { const int row = m0 + ty * 4 + i, b = row >> 12, t = row & 4095;
            for (int j = 0; j < 4; ++j) { const int n = n0 + tx * 4 + j; const float v = acc[i][j];
                if (typ == 0) { const int sh = n >> 6, d = n & 63; st_bf((bf16*)(ws + WS_Q), qk_index(b, sh >> 1, sh & 1, t, d), v * rstd[i] * tab[TB_QG + d]); }
                else if (typ == 1) { const int sh = (n - 512) >> 6, d = n & 63; st_bf((bf16*)(ws + WS_K), qk_index(b, sh >> 1, sh & 1, t, d), v * rstd[i] * tab[TB_KG + d]); }
                else if (typ == 2) { const int c = n - 1024; st_bf((bf16*)(ws + WS_V), v_index(b, c >> 7, t, c & 127), v); }
                else if (typ == 3) { st_bf((bf16*)(ws + WS_GA), (size_t)row * 512 + (n - 1536), siluf_(v)); }
                else if (typ == 4) { const int c = n - 2048; st_bf((bf16*)(ws + WS_U), u_index(b, c >> 4, t, c & 15), v); }
                else if (typ == 5) { st_bf((bf16*)(ws + WS_GS), (size_t)row * 512 + (n - 2560), siluf_(v)); }
                else { const int c = n - 3072; st_bf((bf16*)(ws + WS_MG), (size_t)row * 2048 + c, sigmoidf_(v + a.in[3][c])); } } }
    } else {
        for (int i = 0; i < 4; ++i) { const int row = m0 + ty * 4 + i;
            for (int j = 0; j < 4; ++j) { const int n = n0 + tx * 4 + j; const float v = acc[i][j];
                if (MODE == 3) { const float g = bf2f(((const bf16*)(ws + WS_G))[(size_t)row * 512 + n]); const float gs = bf2f(((const bf16*)(ws + WS_GS))[(size_t)row * 512 + n]);
                    st_bf((bf16*)(ws + WS_OS), (size_t)row * 512 + n, g * sigmoidf_(v + a.in[21][n]) * gs); }
                else if (MODE == 4) { const float ga = bf2f(((const bf16*)(ws + WS_MG))[(size_t)row * 2048 + n]); st_bf((bf16*)(ws + WS_T1), (size_t)row * 1024 + n, ga * v); }
                else if (MODE == 5) { const float gs = bf2f(((const bf16*)(ws + WS_MG))[(size_t)row * 2048 + 1024 + n]); bf16* T1 = (bf16*)(ws + WS_T1); const size_t ix = (size_t)row * 1024 + n; st_bf(T1, ix, bf2f(T1[ix]) + gs * v); }
                else { const size_t ix = (size_t)row * 1024 + n; a.out[ix] = a.in[0][ix] + v; } } }
    }
}

__global__ void __launch_bounds__(256) nk_attn(NArgs a) {
    __shared__ float Qs[2][16][64], Ps[2][16][65];
    unsigned char* ws = a.ws; const float* tab = (const float*)(ws + WS_TAB);
    const bf16* Q = (const bf16*)(ws + WS_Q); const bf16* Kb = (const bf16*)(ws + WS_K); const bf16* V = (const bf16*)(ws + WS_V);
    const int tid = threadIdx.x, ql = tid >> 4, part = tid & 15, q0 = blockIdx.x * 16, h = blockIdx.y, b = blockIdx.z;
    const float m0 = tab[TB_M0], lam = tab[TB_LAM];
    for (int i = tid; i < 2048; i += 256) { const int s = i >> 10, q = (i >> 6) & 15, d = i & 63; Qs[s][q][d] = bf2f(Q[qk_index(b, h, s, q0 + q, d)]); }
    __syncthreads();
    const int ntile = (q0 >> 6) + 1;
    float o[2][8] = {}; float lacc[2] = {0.f, 0.f};
    for (int kt = 0; kt < ntile; ++kt) {
        for (int i = tid; i < 2048; i += 256) { const int s = i >> 10, q = (i >> 6) & 15, k = i & 63, key = kt * 64 + k;
            float dot = 0.f; for (int d = 0; d < 64; ++d) dot += Qs[s][q][d] * bf2f(Kb[qk_index(b, h, s, key, d)]);
            const float bias = (a.in[11][rel_bucket(key - (q0 + q)) * 4 + h] - m0) * LOG2E;
            Ps[s][q][k] = exp2f(dot + bias); }
        __syncthreads();
        for (int s = 0; s < 2; ++s) {
            for (int k = part * 4; k < part * 4 + 4; ++k) lacc[s] += Ps[s][ql][k];
            for (int k = 0; k < 64; ++k) { const float p = Ps[s][ql][k]; const bf16* vr = V + v_index(b, h, kt * 64 + k, part * 8);
                for (int j = 0; j < 8; ++j) o[s][j] += p * bf2f(vr[j]); } }
        __syncthreads();
    }
    for (int s = 0; s < 2; ++s) for (int off = 1; off < 16; off <<= 1) lacc[s] += __shfl_xor(lacc[s], off);
    float ov[8], ss = 0.f;
    for (int j = 0; j < 8; ++j) { ov[j] = o[0][j] / lacc[0] - lam * o[1][j] / lacc[1]; ss += ov[j] * ov[j]; }
    for (int off = 1; off < 16; off <<= 1) ss += __shfl_xor(ss, off);
    const float rstd = rsqrtf(ss * (1.0f / 128.0f) + 1e-6f);
    const size_t row = (size_t)b * SEQ + q0 + ql;
    for (int j = 0; j < 8; ++j) { const int dv = part * 8 + j; const float ga = bf2f(((const bf16*)(ws + WS_GA))[row * 512 + h * 128 + dv]);
        st_bf((bf16*)(ws + WS_OA), row * 512 + h * 128 + dv, ov[j] * rstd * a.in[10][dv] * (1.0f - LAM_INIT) * ga); }
}

__global__ void __launch_bounds__(64) nk_ssm(NArgs a) {
    __shared__ float X[64][129], Us[64][16], cre[16][64], cim[16][64], bbr[64][17], bbi[64][17];
    unsigned char* ws = a.ws; const bf16* U = (const bf16*)(ws + WS_U); bf16* G = (bf16*)(ws + WS_G);
    const int p = threadIdx.x, bg = blockIdx.x, b = bg >> 5, g = bg & 31;
    const SsmConst sc = ssm_const(a.in[12], a.in[13], a.in[14], g, p);
    for (int h = 0; h < 16; ++h) { const double br = a.in[15][(g * SP + p) * 16 + h], bi = a.in[16][(g * SP + p) * 16 + h]; bbr[p][h] = (float)(sc.qr * br - sc.qi * bi); bbi[p][h] = (float)(sc.qr * bi + sc.qi * br); }
    for (int i = p; i < 1024; i += 64) { cre[i >> 6][i & 63] = a.in[17][g * 1024 + i]; cim[i >> 6][i & 63] = a.in[18][g * 1024 + i]; }
    const float lbr = (float)sc.lbr, lbi = (float)sc.lbi; float xr = 0.f, xi = 0.f;
    for (int c0 = 0; c0 < SEQ; c0 += 64) {
        __syncthreads();
        for (int i = p; i < 1024; i += 64) Us[i >> 4][i & 15] = bf2f(U[u_index(b, g, c0 + (i >> 4), i & 15)]);
        __syncthreads();
#pragma unroll 1
        for (int tt = 0; tt < 64; ++tt) { float br = 0.f, bi = 0.f;
#pragma unroll 4
            for (int h = 0; h < 16; ++h) { br += bbr[p][h] * Us[tt][h]; bi += bbi[p][h] * Us[tt][h]; }
            const float nr = lbr * xr - lbi * xi + br, ni = lbr * xi + lbi * xr + bi; xr = nr; xi = ni; X[tt][p] = xr; X[tt][64 + p] = xi; }
        __syncthreads();
#pragma unroll 1
        for (int h = 0; h < 16; ++h) { float y = a.in[19][g * 16 + h] * Us[p][h];
#pragma unroll 4
            for (int pp = 0; pp < 64; ++pp) y += cre[h][pp] * X[p][pp] - cim[h][pp] * X[p][64 + pp];
            st_bf(G, ((size_t)b * SEQ + c0 + p) * 512 + g * 16 + h, gelu_tanh(y)); }
    }
}
#endif
__global__ void __launch_bounds__(NWAVES * 64, 2) mega_fwd(Args args) {
    extern __shared__ __attribute__((aligned(16))) unsigned char lds[];
    Frame F;
    F.lds = (LAS unsigned char*)lds;
    F.MISC = (volatile LAS unsigned*)(F.lds + MISC_OFF);
    F.tid = threadIdx.x; F.lane = F.tid & 63; F.wave = __builtin_amdgcn_readfirstlane(F.tid >> 6);
    F.G = gridDim.x; { const int bx = blockIdx.x; F.vcu = (F.G % 8 == 0) ? (bx % 8) * (F.G / 8) + bx / 8 : bx; }
    unsigned char* ws = args.ws;
    F.ctl = (gu32*)(ws + WS_CTL);
    for (int u = F.tid; u < (LDS_BYTES - LDSCTL_OFF) / 4; u += NWAVES * 64) ((LAS unsigned*)(F.lds + LDSCTL_OFF))[u] = 0u;
    __syncthreads();
    const int lo = args.ph_lo, hi = args.ph_hi;
    XcdBarrier bar; bar.bar = (unsigned*)(F.ctl + CW_BAR) + args.li * XCD_BAR_WORDS; bar.x = 0; bar.st = nullptr;
    if (hi - lo > 1) bar = xcd_barrier_post((unsigned*)(F.ctl + CW_BAR) + args.li * XCD_BAR_WORDS, F.MISC + 8);
#define IN(k) (lo <= (k) && (k) < hi)
#ifdef PROBE_TS
    unsigned long long ts_[10]; int nts_ = 0;
#define STAMP() do { ts_[nts_++] = __builtin_amdgcn_s_memrealtime(); } while (0)
#else
#define STAMP() do {} while (0)
#endif
    STAMP();
#define BOTH(k) (IN(k) && IN((k) + 1))
#ifndef REP_MASK
#define REP_MASK 0
#endif
#ifndef GRP_BARRIERS
#define GRP_BARRIERS 1
#endif
#define NREP(k) (((REP_MASK >> (k)) & 1) ? 2 : 1)
#ifdef PROBE_P0B
    const unsigned long long tp0_ = __builtin_amdgcn_s_memrealtime();
    p0_prologue(F, args);
    const unsigned long long tp1_ = __builtin_amdgcn_s_memrealtime();
    xcd_barrier(bar);
    const unsigned long long tp2_ = __builtin_amdgcn_s_memrealtime();
#else
    if (IN(0)) for (int r_ = 0; r_ < NREP(0); ++r_) { p0_prologue(F, args); if (BOTH(0)) xcd_barrier(bar); }
#endif
    STAMP();
#if FAST_P1
    const bool grp = GRP_BARRIERS && F.G == 256 && lo == 0 && hi == 7; const int gb = F.vcu >> 5;
    XcdBarrier gbar = bar;
    if (grp) { gbar = xcd_barrier_post((unsigned*)(F.ctl + CW_GBAR) + gb * XCD_BAR_WORDS, F.MISC + 10); gbar.nmemb = 32u; }
#define SEAM(k) do { if (grp) xcd_barrier(gbar); else xcd_barrier(bar); } while (0)
    if (IN(1)) for (int r_ = 0; r_ < NREP(1); ++r_) { phase_inproj(F, args); if (BOTH(1)) SEAM(0); }
    STAMP();
#endif
#if FAST_ATT
    if (IN(2)) for (int r_ = 0; r_ < NREP(2); ++r_) { phase_attn(F, args, (char*)lds); }
    STAMP();
#endif
#if FAST_SSM
#ifdef PROBE_SSM
    const unsigned long long tss0_ = __builtin_amdgcn_s_memrealtime();
    if (IN(3)) { phase_ssm(F, args); }
    const unsigned long long tss1_ = __builtin_amdgcn_s_memrealtime();
    if (BOTH(3)) xcd_barrier(bar);
    const unsigned long long tss2_ = __builtin_amdgcn_s_memrealtime();
#else
    if (IN(3)) for (int r_ = 0; r_ < NREP(3); ++r_) { phase_ssm(F, args); if (BOTH(3)) SEAM(1); }
#endif
    STAMP();
#endif
#if FAST_P4
    if (IN(4)) for (int r_ = 0; r_ < NREP(4); ++r_) { phase_glu_t1(F, args); if (BOTH(4)) SEAM(2); }
    STAMP();
#endif
#if FAST_P5
    if (IN(5)) { phase_merge(F, args); if (BOTH(5)) SEAM(3); }
    STAMP();
#endif
#if FAST_P6
    if (IN(6)) for (int r_ = 0; r_ < NREP(6); ++r_) { phase_out(F, args); }
    STAMP();
#ifdef PROBE_TS
    xcd_barrier(bar); STAMP();
#endif
#ifdef PROBE_P0B
    if (blockIdx.x == PROBE_BLK) { const unsigned long long d_ = (PROBE_P0B == 1) ? (tp1_ - tp0_) : (tp2_ - tp1_), t0_ = __builtin_amdgcn_s_memrealtime(); while (__builtin_amdgcn_s_memrealtime() - t0_ < d_) __builtin_amdgcn_s_sleep(8); }
#endif
#ifdef PROBE_SSM
    if (blockIdx.x == 0) { const unsigned long long d_ = (PROBE_SSM == 1) ? (tss1_ - tss0_) : (tss2_ - tss1_), t0_ = __builtin_amdgcn_s_memrealtime(); while (__builtin_amdgcn_s_memrealtime() - t0_ < d_) __builtin_amdgcn_s_sleep(8); }
#endif
#ifdef PROBE_EPI
    if (blockIdx.x == 0) { __syncthreads(); const unsigned long long d_ = ((unsigned long long)F.MISC[27] << 32) | F.MISC[26], t0_ = __builtin_amdgcn_s_memrealtime(); while (__builtin_amdgcn_s_memrealtime() - t0_ < d_) __builtin_amdgcn_s_sleep(8); }
#endif
#ifdef PROBE_ATT
    if (blockIdx.x == 0) { __syncthreads(); const unsigned long long d_ = ((unsigned long long)F.MISC[25] << 32) | F.MISC[24], t0_ = __builtin_amdgcn_s_memrealtime(); while (__builtin_amdgcn_s_memrealtime() - t0_ < d_) __builtin_amdgcn_s_sleep(8); }
#endif
#ifdef PROBE_P0
    if (blockIdx.x == 0) { __syncthreads(); const unsigned long long a_ = ((unsigned long long)F.MISC[17 + 2 * PROBE_P0] << 32) | F.MISC[16 + 2 * PROBE_P0], b_ = ((unsigned long long)F.MISC[19 + 2 * PROBE_P0] << 32) | F.MISC[18 + 2 * PROBE_P0];
        const unsigned long long d_ = b_ - a_, t0_ = __builtin_amdgcn_s_memrealtime(); while (__builtin_amdgcn_s_memrealtime() - t0_ < d_) __builtin_amdgcn_s_sleep(8); }
#endif
#ifdef PROBE_TS
    if (blockIdx.x == 0) { const unsigned long long d_ = ts_[PROBE_TS + 1] - ts_[PROBE_TS], t0_ = __builtin_amdgcn_s_memrealtime(); while (__builtin_amdgcn_s_memrealtime() - t0_ < d_) __builtin_amdgcn_s_sleep(8); }
#endif
#endif
#undef IN
#undef BOTH
}

extern "C" void kernel_launch(void* const* d_in, const int* in_sizes, int n_in, void* d_out, int out_size, void* d_ws, size_t ws_size, hipStream_t stream) {
    static int grid = 0;
    if (grid == 0) {
        if (n_in != 25 || in_sizes[0] != MTOK * DM || out_size != MTOK * DM || ws_size < WS_TOTAL) { fprintf(stderr, "kernel_launch: unexpected shapes/workspace (n_in %d, in0 %d, out %d, ws %zu)\n", n_in, n_in > 0 ? in_sizes[0] : -1, out_size, ws_size); grid = -1; return; }
        int dev = 0, cus = 0, per_cu = 0;
        if (hipGetDevice(&dev) != hipSuccess || hipDeviceGetAttribute(&cus, hipDeviceAttributeMultiprocessorCount, dev) != hipSuccess) { grid = -1; return; }
        if (hipFuncSetAttribute((const void*)mega_fwd, hipFuncAttributeMaxDynamicSharedMemorySize, LDS_BYTES) != hipSuccess) { fprintf(stderr, "kernel_launch: hipFuncSetAttribute failed\n"); grid = -1; return; }
        if (hipOccupancyMaxActiveBlocksPerMultiprocessor(&per_cu, (const void*)mega_fwd, NWAVES * 64, LDS_BYTES) != hipSuccess || per_cu < 1) fprintf(stderr, "kernel_launch: occupancy query reports %d\n", per_cu);
        (void)hipGetLastError();
        grid = cus;
    }
    if (grid < 0) return;
    if (hipMemsetAsync((char*)d_ws + WS_CTL, 0, CTL_ZERO_BYTES, stream) != hipSuccess) return;
    Args a{};
    for (int i = 0; i < 25; ++i) a.in[i] = (const float*)d_in[i];
    a.out = (float*)d_out; a.ws = (unsigned char*)d_ws;
#if USE_NAIVE
    NArgs na{}; for (int i = 0; i < 25; ++i) na.in[i] = (const float*)d_in[i]; na.out = (float*)d_out; na.ws = (unsigned char*)d_ws;
#define MEGA(lo_, hi_) do { a.ph_lo = (lo_); a.ph_hi = (hi_); hipLaunchKernelGGL(mega_fwd, dim3(grid), dim3(NWAVES * 64), LDS_BYTES, stream, a); } while (0)
    MEGA(0, 1);
#ifdef DBG_POISON_P1
    (void)hipMemsetAsync((char*)d_ws + WS_Q, 0xFF, 64 * MiB + 32 * MiB + 32 * MiB, stream);
    (void)hipMemsetAsync((char*)d_ws + WS_U, 0xFF, 48 * MiB + 32 * MiB + 128 * MiB, stream);
#endif
#if FAST_P1
    MEGA(1, 2);
#else
    hipLaunchKernelGGL(nk_gemm<1>, dim3(NCOL / 64, MTOK / 64), dim3(256), 0, stream, na);
#endif
#if FAST_ATT
    MEGA(2, 3);
#else
    hipLaunchKernelGGL(nk_attn, dim3(SEQ / 16, NH, BATCH), dim3(256), 0, stream, na);
#endif
#if FAST_SSM
    MEGA(3, 4);
#else
    hipLaunchKernelGGL(nk_ssm, dim3(BATCH * NG), dim3(64), 0, stream, na);
#endif
#if FAST_P4
    MEGA(4, 5);
#else
    hipLaunchKernelGGL(nk_gemm<3>, dim3(512 / 64, MTOK / 64), dim3(256), 0, stream, na);
    hipLaunchKernelGGL(nk_gemm<4>, dim3(1024 / 64, MTOK / 64), dim3(256), 0, stream, na);
#endif
#if FAST_P5
    MEGA(5, 6);
#else
    hipLaunchKernelGGL(nk_gemm<5>, dim3(1024 / 64, MTOK / 64), dim3(256), 0, stream, na);
#endif
#if FAST_P6
    MEGA(6, 7);
#else
    hipLaunchKernelGGL(nk_gemm<6>, dim3(1024 / 64, MTOK / 64), dim3(256), 0, stream, na);
#endif
#undef MEGA
#else
#define MEGA(lo_, hi_) do { a.ph_lo = (lo_); a.ph_hi = (hi_); hipLaunchKernelGGL(mega_fwd, dim3(grid), dim3(NWAVES * 64), LDS_BYTES, stream, a); ++a.li; } while (0)
#if defined(PROBE_MODE) && PROBE_MODE == 1
    MEGA(0, 3); MEGA(3, 4); MEGA(3, 4); MEGA(4, 7);
#elif defined(PROBE_MODE) && PROBE_MODE == 2
    MEGA(0, 6); MEGA(4, 6); MEGA(6, 7);
#elif defined(PROBE_MODE) && PROBE_MODE == 3
    MEGA(0, 3); MEGA(3, 4); MEGA(4, 7);
#else
    MEGA(0, 7);
#endif
#undef MEGA
#endif
    const hipError_t le = hipPeekAtLastError();
    if (le != hipSuccess) fprintf(stderr, "kernel_launch: launch failed: %s\n", hipGetErrorName(le));
}
```

```cpp
#define USE_NAIVE 0
#define FAST_P1 1
#define FAST_ATT 1
#define FAST_SSM 1
#define FAST_P4 1
#define FAST_P5 1
#define FAST_P6 1

#include <hip/hip_runtime.h>
#include <cstdio>
#include <cstdint>
#include <cmath>

constexpr int BATCH = 8, SEQ = 4096, DM = 1024, MTOK = BATCH * SEQ;
constexpr int NCOL = 5120;
constexpr int AW = 512, NH = 4, SD = 64, VD = 128, SW = 512, SGC = 16, NG = 32, SP = 64;
constexpr int TCH = 16;
constexpr int NCH = SEQ / TCH;
constexpr int ALD = 384;
constexpr float LOG2E = 1.4426950408889634f;
constexpr float LAM_INIT = 0.2f;

constexpr size_t MiB = 1u << 20;
constexpr size_t WS_CTL = 0, CTL_ZERO_BYTES = 256 * 1024;
constexpr size_t WS_TAB = 1 * MiB;
constexpr size_t WS_WIN = 2 * MiB;
constexpr size_t WS_GLUW = 12 * MiB;
constexpr size_t WS_PAS = 13 * MiB;
constexpr size_t WS_WOUT = 15 * MiB;
constexpr size_t WS_W2 = 17 * MiB;
constexpr size_t WS_KW = 21 * MiB;
constexpr size_t WS_G = 27 * MiB;
constexpr size_t WS_XN = 64 * MiB;
constexpr size_t WS_OAS = 64 * MiB;
constexpr size_t WS_Q = 128 * MiB;
constexpr size_t QKB = 4194304, QKK = 2097152;
constexpr size_t WS_MRG = 128 * MiB;
constexpr size_t WS_V = 192 * MiB;
constexpr size_t WS_GA = 224 * MiB;
constexpr size_t WS_U = 256 * MiB;
constexpr size_t WS_GS = 304 * MiB;
constexpr size_t WS_MG = 336 * MiB;
constexpr size_t WS_TOTAL = 464 * MiB;

constexpr int TB_LAM = 0;
constexpr int TB_M0 = 1;
constexpr int TB_CFAR = 4;
constexpr int TB_QG = 64;
constexpr int TB_KG = 128;
constexpr int TB_BIASL = 256;
constexpr int TB_LB16 = 2048;

typedef unsigned short bf16;
typedef unsigned v4u __attribute__((ext_vector_type(4)));
typedef unsigned v2u __attribute__((ext_vector_type(2)));

__host__ __device__ __forceinline__ unsigned f2bf(float f) { unsigned u = __builtin_bit_cast(unsigned, f); return (u + 0x7fffu + ((u >> 16) & 1u)) >> 16; }
__host__ __device__ __forceinline__ float bf2f(unsigned h) { return __builtin_bit_cast(float, (h & 0xffffu) << 16); }
__device__ __forceinline__ unsigned pk2(float lo, float hi) { return f2bf(lo) | (f2bf(hi) << 16); }

__host__ __device__ __forceinline__ size_t qk_index(int b, int h, int s, int t, int d) {
    return (size_t)b * QKB + ((((size_t)(h * 2 + s) * 64 + (t >> 6)) * 8 + (d >> 3)) * 64 + (t & 63)) * 8 + (d & 7);
}
__host__ __device__ __forceinline__ size_t v_index(int b, int h, int t, int dv) { return ((size_t)(b * 4 + h) * SEQ + t) * VD + dv; }
__host__ __device__ __forceinline__ size_t u_index(int b, int g, int t, int hc) { return ((size_t)(b * NG + g) * NCH + (t >> 4)) * ALD + (t & 15) * 16 + hc; }
__host__ __device__ __forceinline__ int rowmap_in(int n) {
    if (n >= 3072) { const int c = n - 3072, isS = c >> 10, ch = c & 1023; return 3072 + 256 * (ch >> 7) + 128 * isS + (ch & 127); }
    if (n >= 1024) return n;
    const int tile = n >> 8, ow = n & 255, wc = ow >> 6, rem = ow & 63, bj = rem >> 5, i = rem & 31;
    return tile * 256 + 128 * bj + 32 * wc + i;
}
__device__ __forceinline__ int rel_bucket(int rel) {
    const int side = rel > 0 ? 16 : 0; const int n = rel < 0 ? -rel : rel; int b;
    if (n < 8) b = n;
    else b = n >= 91 ? 15 : n >= 64 ? 14 : n >= 46 ? 13 : n >= 32 ? 12 : n >= 23 ? 11 : n >= 16 ? 10 : n >= 12 ? 9 : 8;
    return side + b;
}
__device__ __forceinline__ float sigmoidf_(float x) { return __builtin_amdgcn_rcpf(1.0f + __builtin_amdgcn_exp2f(-LOG2E * x)); }
__device__ __forceinline__ float siluf_(float x) { return x * __builtin_amdgcn_rcpf(1.0f + __builtin_amdgcn_exp2f(-LOG2E * x)); }
__device__ __forceinline__ float gelu_tanh(float x) {
    const float u = 0.7978845608028654f * (x + 0.044715f * x * x * x);
    const float e = __builtin_amdgcn_exp2f(-2.0f * LOG2E * u);
    return x * __builtin_amdgcn_rcpf(1.0f + e);
}
__device__ __forceinline__ void sincos_d(double x, double& s, double& c) {
    const double TWO_PI = 6.283185307179586476925286766559;
    const double k = rint(x / TWO_PI); x -= k * TWO_PI;
    const double x2 = x * x; double term = x; s = x;
#pragma unroll
    for (int n = 1; n <= 16; ++n) { term *= -x2 * (1.0 / (double)((2 * n) * (2 * n + 1))); s += term; }
    term = 1.0; c = 1.0;
#pragma unroll
    for (int n = 1; n <= 16; ++n) { term *= -x2 * (1.0 / (double)((2 * n - 1) * (2 * n))); c += term; }
}
__device__ __forceinline__ double exp_d(double x) {
    int k = 0; double ax = x < 0 ? -x : x; while (ax > 0.25) { ax *= 0.5; ++k; }
    const double y = x / (double)(1 << k); double term = 1.0, s = 1.0;
#pragma unroll
    for (int n = 1; n <= 14; ++n) { term *= y * (1.0 / (double)n); s += term; }
    for (int i = 0; i < k; ++i) s *= s;
    return s;
}
struct SsmConst { double lbr, lbi, qr, qi; };
__device__ __forceinline__ SsmConst ssm_const(const float* A_re, const float* A_im, const float* log_dt, int g, int p) {
    const double dt = exp_d((double)log_dt[g]); const double ar = (double)A_re[g * SP + p], ai = (double)A_im[g * SP + p];
    const double dec = exp_d(ar * dt); double sn, cs; sincos_d(ai * dt, sn, cs);
    SsmConst r; r.lbr = dec * cs; r.lbi = dec * sn;
    const double nr = r.lbr - 1.0, ni = r.lbi, den = ar * ar + ai * ai;
    r.qr = (nr * ar + ni * ai) / den; r.qi = (ni * ar - nr * ai) / den; return r;
}
#define GAS __attribute__((address_space(1)))
#define LAS __attribute__((address_space(3)))
typedef float f32x4 __attribute__((ext_vector_type(4)));
typedef short bf16x8 __attribute__((ext_vector_type(8)));
typedef GAS unsigned gu32;
typedef GAS unsigned long long gu64;
#define RLX_AGENT __ATOMIC_RELAXED, __HIP_MEMORY_SCOPE_AGENT
#define LDS_WAIT() asm volatile("s_waitcnt lgkmcnt(0)" ::: "memory")
#define VM_WAIT() asm volatile("s_waitcnt vmcnt(0)" ::: "memory")
__device__ __forceinline__ unsigned long long rt() { return __builtin_amdgcn_s_memrealtime(); }
#define XB_TMO      128
#define XB_XCNT(j)  (256  + 64 * (j))
#define XB_XSUB(j)  (1280 + 64 * (j))
#define XB_XGEN(j)  (2304 + 64 * (j))
#define XB_TOP      3328
#define XB_TOPGEN   3392
#define XCD_BAR_WORDS 3456
#define XB_SPIN_CAP (1u << 18)

__device__ __forceinline__ unsigned xb_ld(unsigned* p)              { return __hip_atomic_load(p, __ATOMIC_RELAXED, __HIP_MEMORY_SCOPE_AGENT); }
__device__ __forceinline__ unsigned xb_add(unsigned* p, unsigned v) { return __hip_atomic_fetch_add(p, v, __ATOMIC_RELAXED, __HIP_MEMORY_SCOPE_AGENT); }
__device__ __forceinline__ unsigned xb_xcc_id() { return (unsigned)__builtin_amdgcn_s_getreg((3 << 11) | 20) & 0xFu; }
#define XB_SPIN(cond, bar) do { unsigned _sp = 0; while (cond) { __builtin_amdgcn_s_sleep(1); \
    if ((++_sp & 255u) == 0u) { if (xb_ld(&(bar)[XB_TMO])) break; if (_sp > XB_SPIN_CAP) { atomicAdd(&(bar)[XB_TMO], 1u); break; } } } } while (0)

struct XcdBarrier {
    unsigned* bar; unsigned x; unsigned nmemb;
    volatile LAS unsigned* st;
};

__device__ __forceinline__ XcdBarrier xcd_barrier_post(unsigned* bar, volatile LAS unsigned* st) {
    XcdBarrier b; b.bar = bar; b.x = xb_xcc_id(); b.st = st; b.nmemb = 0u;
    if (threadIdx.x == 0) (void)xb_add(&bar[XB_XCNT(b.x)], 1u);
    return b;
}
__device__ __forceinline__ void xcd_barrier_complete(unsigned* bar, unsigned x, unsigned& nloc, unsigned& nx, unsigned nmemb) {
    const unsigned G = nmemb ? nmemb : gridDim.x * gridDim.y * gridDim.z;
    unsigned sum, cnt, mine, sp = 0u;
    for (;;) {
        sum = 0u; cnt = 0u; mine = 0u;
#pragma unroll
        for (unsigned j = 0; j < 16; ++j) { const unsigned c = xb_ld(&bar[XB_XCNT(j)]); sum += c; cnt += (c > 0u) ? 1u : 0u; mine = (j == x) ? c : mine; }
        if (sum == G) break;
        __builtin_amdgcn_s_sleep(1);
        if ((++sp & 255u) == 0u) { if (xb_ld(&bar[XB_TMO])) break; if (sp > XB_SPIN_CAP) { atomicAdd(&bar[XB_TMO], 1u); break; } }
    }
    nloc = mine > 0u ? mine : 1u; nx = cnt > 0u ? cnt : 1u;
}

__device__ __forceinline__ void xcd_barrier(const XcdBarrier& b) {
    asm volatile("s_waitcnt vmcnt(0)" ::: "memory");
    __syncthreads();
    if (threadIdx.x == 0) {
        unsigned* bar = b.bar;
        __builtin_amdgcn_s_waitcnt(0);
        unsigned nloc = b.st[0], nx = b.st[1];
        if (nloc == 0u) { xcd_barrier_complete(bar, b.x, nloc, nx, b.nmemb); b.st[0] = nloc; b.st[1] = nx; }
        const unsigned old = xb_add(&bar[XB_XSUB(b.x)], 1u);
        const unsigned gen = old / nloc;
        if (old + 1u == (gen + 1u) * nloc) {
            if (!(b.nmemb != 0u && nx == 1u)) {
            __builtin_amdgcn_fence(__ATOMIC_RELEASE, "agent");
            }
            asm volatile("s_waitcnt vmcnt(0)" ::: "memory");
            if (nx > 1u) {
            const unsigned og = xb_add(&bar[XB_TOP], 1u);
            const unsigned tg = og / nx;
            if (og + 1u == (tg + 1u) * nx) xb_add(&bar[XB_TOPGEN], 1u);
            else XB_SPIN(xb_ld(&bar[XB_TOPGEN]) == tg, bar);
            }
            __builtin_amdgcn_fence(__ATOMIC_ACQUIRE, "agent");
            xb_add(&bar[XB_XGEN(b.x)], 1u);
            asm volatile("s_waitcnt vmcnt(0)" ::: "memory");
        } else {
            XB_SPIN(xb_ld(&bar[XB_XGEN(b.x)]) == gen, bar);
            __builtin_amdgcn_fence(__ATOMIC_ACQUIRE, "agent");
            asm volatile("s_waitcnt vmcnt(0)" ::: "memory");
        }
    }
    __syncthreads();
}
#ifndef PG8_WGM
#define PG8_WGM 8
#endif
namespace pg8 {
#define PG8_LAS __attribute__((address_space(3)))
typedef unsigned short bf16_t;
typedef short bf16x8 __attribute__((ext_vector_type(8)));
typedef float f32x4 __attribute__((ext_vector_type(4)));
typedef unsigned u32x4 __attribute__((ext_vector_type(4)));
constexpr int BM = 256, BK = 64, HALF = 128, HTB = HALF * BK * 2  , STAGE_BYTES = 8 * HTB, NXCD = 8, WGM = PG8_WGM;

__host__ __device__ __forceinline__ int lds_byte(int r, int c) { const int st = (r >> 4) * 2 + (c >> 5), rr = r & 15, cc = c & 31, ob = rr * 64 + cc * 2; return st * 1024 + (ob ^ (((ob >> 9) & 1) << 5)); }
__host__ __device__ __forceinline__ void stage_rc(int b, int& R, int& C) { const int st = b / 1024, sb = b % 1024, swz = sb ^ (((sb >> 9) & 1) << 5); R = (st >> 1) * 16 + swz / 64; C = (st & 1) * 32 + (swz % 64) / 2; }
__host__ __device__ __forceinline__ int perm32(int rho) { const int n = rho >> 4, i = rho & 15; return 8 * (i >> 2) + 4 * n + (i & 3); }

struct Unit { int pm, pn; };
struct Gemm { const bf16_t* A; const bf16_t* Bt; int M, N, K, lda, ldb; };

struct StaticOrder {
    int nM, nN, nwg, G, c;
    __host__ __device__ void init(int M, int N, int G_, int c_) { nM = M / BM; nN = N / BM; nwg = nM * nN; G = G_; c = c_; }
    __host__ __device__ bool next(int i, Unit& u) const {
        const long L = (long)i * G + c; if (L >= nwg) return false;
        int wgid = (int)L; { const int q = nwg / NXCD, r = nwg % NXCD, xcd = wgid % NXCD, off = wgid / NXCD; wgid = (xcd < r ? xcd * (q + 1) : r * (q + 1) + (xcd - r) * q) + off; }
        const int nig = WGM * nN, gid = wgid / nig, fm = gid * WGM, gsz = (nM - fm) < WGM ? (nM - fm) : WGM;
        u.pm = fm + ((wgid % nig) % gsz); u.pn = (wgid % nig) / gsz; return true;
    }
    __device__ __forceinline__ void a_ready(const Unit&) const {}
    __device__ __forceinline__ void done(const Unit&) const {}
};

typedef float f32x2_cv __attribute__((ext_vector_type(2))); typedef __bf16 bf16x2_cv __attribute__((ext_vector_type(2)));
__device__ __forceinline__ unsigned cvt_pk_bf16(float lo, float hi) { f32x2_cv v = {lo, hi}; bf16x2_cv b = __builtin_convertvector(v, bf16x2_cv); return __builtin_bit_cast(unsigned, b); }
typedef float f32x2 __attribute__((ext_vector_type(2)));
template <class Epi, class Sched, bool ALIGN_EPI = false, bool SP2 = false, int KMID = 0>
__device__ __forceinline__ void gemm_phase(PG8_LAS unsigned char* lds, const Gemm g, const Sched& S, const Epi& E) {
    int tid_ = threadIdx.x; asm volatile("" : "+v"(tid_));
    const int tid = tid_, wid = __builtin_amdgcn_readfirstlane(tid >> 6), lane = tid & 63, wr = wid >> 2, wc = wid & 3, fr = lane & 15, fq = lane >> 4;
    const int K = g.K, nt = K / BK;
    unsigned voffA[2], voffB[2];
#pragma unroll
    for (int i = 0; i < 2; ++i) { int R, C; stage_rc(tid * 16 + i * 8192, R, C); const int Rb = Epi::PERM ? ((R & ~31) + perm32(R & 31)) : R;
        voffA[i] = (unsigned)(R * g.lda + C) * 2u; voffB[i] = (unsigned)(Rb * g.ldb + C) * 2u; }
    const size_t kstep = (size_t)(BK * 2);
    const size_t hstepA = (size_t)HALF * g.lda * 2, hstepB = (size_t)HALF * g.ldb * 2;
    const size_t tstepA = 2 * hstepA, tstepB = 2 * hstepB;
    const unsigned ldsw = (unsigned)wid * 1024u;
    const int aoff = lds_byte(wr * 64 + fr, fq * 8), boff = lds_byte(wc * 32 + fr, fq * 8);
#define PG8_SA(b, h) (((b) * 2 + (h)) * HTB)
#define PG8_SB(b, h) ((4 + (b) * 2 + (h)) * HTB)
#define PG8_STAGE(bufoff, gbase, voff) do { _Pragma("unroll") for (int _i = 0; _i < 2; ++_i) \
        __builtin_amdgcn_global_load_lds((const unsigned*)((const char*)(gbase) + (voff)[_i]), (PG8_LAS unsigned*)(lds + (bufoff) + ldsw + _i * 8192), 16, 0, 0); } while (0)
#define PG8_LDA(dst, b, h) do { _Pragma("unroll") for (int m = 0; m < 4; ++m) _Pragma("unroll") for (int k = 0; k < 2; ++k) dst[m][k] = *(const PG8_LAS bf16x8*)(lds + PG8_SA(b, h) + aoff + m * 2048 + k * 1024); } while (0)
#define PG8_LDB(dst, b, h) do { _Pragma("unroll") for (int n = 0; n < 2; ++n) _Pragma("unroll") for (int k = 0; k < 2; ++k) dst[n][k] = *(const PG8_LAS bf16x8*)(lds + PG8_SB(b, h) + boff + n * 2048 + k * 1024); } while (0)
#define PG8_MMA(ai, bj, At, Bt) do { __builtin_amdgcn_s_setprio(1); _Pragma("unroll") for (int m = 0; m < 4; ++m) _Pragma("unroll") for (int n = 0; n < 2; ++n) _Pragma("unroll") for (int k = 0; k < 2; ++k) \
        acc[ai][bj][m][n] = __builtin_amdgcn_mfma_f32_16x16x32_bf16(Bt[n][k], At[m][k], acc[ai][bj][m][n], 0, 0, 0); __builtin_amdgcn_s_setprio(0); } while (0)
#define PG8_WAIT_V(n) asm volatile("s_waitcnt vmcnt(" #n ")" ::: "memory")
#define PG8_WAIT_L(n) asm volatile("s_waitcnt lgkmcnt(" #n ")" ::: "memory")
#define PG8_BAR __builtin_amdgcn_s_barrier()
#define PG8_SCHED __builtin_amdgcn_sched_barrier(0)
    Unit cur, nxt; int ui = 0;
    if (!S.next(0, cur)) return;
    f32x4 acc[2][2][4][2];
#pragma unroll
    for (int a = 0; a < 2; ++a)
#pragma unroll
        for (int b = 0; b < 2; ++b)
#pragma unroll
            for (int m = 0; m < 4; ++m)
#pragma unroll
                for (int n = 0; n < 2; ++n) acc[a][b][m][n] = (f32x4){0.f, 0.f, 0.f, 0.f};
    bf16x8 At[4][2], B0[2][2], B1[2][2];
    const char* cA = (const char*)g.A + (size_t)cur.pm * tstepA; const char* cB = (const char*)g.Bt + (size_t)cur.pn * tstepB;
    S.a_ready(cur);
    if constexpr (SP2) {
        PG8_STAGE(PG8_SB(0, 0), cB, voffB); PG8_STAGE(PG8_SB(0, 1), cB + hstepB, voffB); PG8_STAGE(PG8_SA(0, 0), cA, voffA); PG8_STAGE(PG8_SA(0, 1), cA + hstepA, voffA);
        if (wr == 1) PG8_BAR;
        PG8_WAIT_V(2); PG8_BAR;
        PG8_STAGE(PG8_SB(1, 0), cB + kstep, voffB); PG8_STAGE(PG8_SA(1, 0), cA + kstep, voffA); PG8_STAGE(PG8_SB(1, 1), cB + hstepB + kstep, voffB);
        PG8_WAIT_V(6); PG8_BAR;
    } else {
        PG8_STAGE(PG8_SB(0, 0), cB, voffB); PG8_STAGE(PG8_SA(0, 0), cA, voffA); PG8_STAGE(PG8_SB(0, 1), cB + hstepB, voffB); PG8_STAGE(PG8_SA(0, 1), cA + hstepA, voffA);
        if (wr == 1) PG8_BAR;
        PG8_WAIT_V(4); PG8_BAR;
        PG8_STAGE(PG8_SB(1, 0), cB + kstep, voffB); PG8_STAGE(PG8_SA(1, 0), cA + kstep, voffA); PG8_STAGE(PG8_SB(1, 1), cB + hstepB + kstep, voffB);
        PG8_WAIT_V(6); PG8_BAR;
    }
    for (;;) {
        const bool has_next = S.next(ui + 1, nxt);
        const char* nA = has_next ? (const char*)g.A + (size_t)nxt.pm * tstepA : cA; const char* nB = has_next ? (const char*)g.Bt + (size_t)nxt.pn * tstepB : cB;
        for (int t = 0; t < nt; t += 2) {
            if constexpr (KMID != 0) { if (t == KMID / BK) E.mid(acc, cur, wr, wc, fr, fq); }
            const bool last = (t == nt - 2);
            const char* a1 = cA + (size_t)(t + 1) * kstep;
            const char* a2 = last ? nA : cA + (size_t)(t + 2) * kstep; const char* b2 = last ? nB : cB + (size_t)(t + 2) * kstep;
            const char* a3 = a2 + kstep; const char* b3 = b2 + kstep;
            if (last && has_next) S.a_ready(nxt);
            if constexpr (SP2) {
            PG8_LDB(B0, 0, 0); PG8_LDB(B1, 0, 1); PG8_SCHED; PG8_LDA(At, 0, 0); PG8_STAGE(PG8_SA(1, 1), a1 + hstepA, voffA);
            PG8_WAIT_V(8); PG8_WAIT_L(0); PG8_BAR; PG8_MMA(0, 0, At, B0); PG8_MMA(0, 1, At, B1); PG8_BAR; PG8_SCHED;
            PG8_LDA(At, 0, 1); PG8_STAGE(PG8_SB(0, 0), b2, voffB); PG8_STAGE(PG8_SB(0, 1), b2 + hstepB, voffB); PG8_STAGE(PG8_SA(0, 0), a2, voffA);
            PG8_WAIT_V(8); PG8_WAIT_L(0); PG8_BAR; PG8_MMA(1, 0, At, B0); PG8_MMA(1, 1, At, B1); PG8_BAR; PG8_SCHED;
            PG8_LDB(B0, 1, 0); PG8_LDB(B1, 1, 1); PG8_SCHED; PG8_LDA(At, 1, 0); PG8_STAGE(PG8_SA(0, 1), a2 + hstepA, voffA);
            PG8_WAIT_V(8); PG8_WAIT_L(0); PG8_BAR; PG8_MMA(0, 0, At, B0); PG8_MMA(0, 1, At, B1); PG8_BAR; PG8_SCHED;
            PG8_LDA(At, 1, 1); PG8_STAGE(PG8_SB(1, 0), b3, voffB); PG8_STAGE(PG8_SB(1, 1), b3 + hstepB, voffB); PG8_STAGE(PG8_SA(1, 0), a3, voffA);
            PG8_WAIT_V(8); PG8_WAIT_L(0); PG8_BAR; PG8_MMA(1, 0, At, B0); PG8_MMA(1, 1, At, B1); PG8_BAR; PG8_SCHED;
            } else {
            PG8_LDB(B0, 0, 0); PG8_SCHED; PG8_LDA(At, 0, 0); PG8_STAGE(PG8_SA(1, 1), a1 + hstepA, voffA);
            PG8_WAIT_L(8); PG8_BAR; PG8_WAIT_L(0); PG8_MMA(0, 0, At, B0); PG8_BAR; PG8_SCHED;
            PG8_LDB(B1, 0, 1); PG8_STAGE(PG8_SB(0, 0), b2, voffB);
            PG8_BAR; PG8_WAIT_L(0); PG8_MMA(0, 1, At, B1); PG8_BAR;
            PG8_LDA(At, 0, 1); PG8_STAGE(PG8_SA(0, 0), a2, voffA);
            PG8_BAR; PG8_WAIT_L(0); PG8_MMA(1, 0, At, B0); PG8_BAR; PG8_SCHED;
            PG8_STAGE(PG8_SB(0, 1), b2 + hstepB, voffB);
            PG8_WAIT_V(6); PG8_BAR; PG8_MMA(1, 1, At, B1); PG8_BAR;
            PG8_LDB(B0, 1, 0); PG8_SCHED; PG8_LDA(At, 1, 0); PG8_STAGE(PG8_SA(0, 1), a2 + hstepA, voffA);
            PG8_WAIT_L(8); PG8_BAR; PG8_WAIT_L(0); PG8_MMA(0, 0, At, B0); PG8_BAR; PG8_SCHED;
            PG8_LDB(B1, 1, 1); PG8_STAGE(PG8_SB(1, 0), b3, voffB);
            PG8_BAR; PG8_WAIT_L(0); PG8_MMA(0, 1, At, B1); PG8_BAR;
            PG8_LDA(At, 1, 1); PG8_STAGE(PG8_SA(1, 0), a3, voffA);
            PG8_BAR; PG8_WAIT_L(0); PG8_MMA(1, 0, At, B0); PG8_BAR; PG8_SCHED;
            PG8_STAGE(PG8_SB(1, 1), b3 + hstepB, voffB);
            PG8_WAIT_V(6); PG8_BAR; PG8_MMA(1, 1, At, B1); PG8_BAR;
            }
        }
        if constexpr (ALIGN_EPI) { if (wr == 0) PG8_BAR; }
#ifdef PROBE_EPI
        const unsigned long long te0_ = __builtin_amdgcn_s_memrealtime();
#endif
        if constexpr (!Epi::AFTER_DRAIN) { E(acc, cur, wr, wc, fr, fq); S.done(cur); }
#ifdef PROBE_EPI
        if (tid == 0) { volatile PG8_LAS unsigned* mm = (volatile PG8_LAS unsigned*)(lds + 131072 + 320); const unsigned long long d_ = __builtin_amdgcn_s_memrealtime() - te0_; const unsigned long long acc_ = (((unsigned long long)mm[27] << 32) | mm[26]) + d_; mm[26] = (unsigned)acc_; mm[27] = (unsigned)(acc_ >> 32); }
#endif
        if (!has_next) break;
#pragma unroll
        for (int a = 0; a < 2; ++a)
#pragma unroll
            for (int b = 0; b < 2; ++b)
#pragma unroll
                for (int m = 0; m < 4; ++m)
#pragma unroll
                    for (int n = 0; n < 2; ++n) acc[a][b][m][n] = (f32x4){0.f, 0.f, 0.f, 0.f};
        cur = nxt; cA = nA; cB = nB; ++ui;
        if constexpr (ALIGN_EPI) { if (wr == 1) PG8_BAR; }
    }
    PG8_WAIT_V(0);
    if constexpr (!ALIGN_EPI) { if (wr == 0) PG8_BAR; }
    PG8_BAR;
    if constexpr (Epi::AFTER_DRAIN) { E.fused(acc, cur, wr, wc, fr, fq, lds, wid, lane); S.done(cur); }
#undef PG8_SA
#undef PG8_SB
#undef PG8_STAGE
#undef PG8_LDA
#undef PG8_LDB
#undef PG8_MMA
#undef PG8_WAIT_V
#undef PG8_WAIT_L
#undef PG8_BAR
#undef PG8_SCHED
}
}
namespace pg8 {
#ifdef EPI_SC1
__device__ __forceinline__ void st16(void* p, const u32x4 v) { asm volatile("global_store_dwordx4 %0, %1, off sc1\n\ts_nop 1" :: "v"(p), "v"(v) : "memory"); }
#else
__device__ __forceinline__ void st16(void* p, const u32x4 v) { *(u32x4*)p = v; }
#endif
__device__ __forceinline__ u32x4 pack8(const f32x4 a, const f32x4 b) { u32x4 w; w.x = cvt_pk_bf16(a[0], a[1]); w.y = cvt_pk_bf16(a[2], a[3]); w.z = cvt_pk_bf16(b[0], b[1]); w.w = cvt_pk_bf16(b[2], b[3]); return w; }
__device__ __forceinline__ void unpack8(const u32x4 w, f32x4& a, f32x4& b) {
    a[0] = __builtin_bit_cast(float, w.x << 16); a[1] = __builtin_bit_cast(float, w.x & 0xffff0000u); a[2] = __builtin_bit_cast(float, w.y << 16); a[3] = __builtin_bit_cast(float, w.y & 0xffff0000u);
    b[0] = __builtin_bit_cast(float, w.z << 16); b[1] = __builtin_bit_cast(float, w.z & 0xffff0000u); b[2] = __builtin_bit_cast(float, w.w << 16); b[3] = __builtin_bit_cast(float, w.w & 0xffff0000u);
}
__device__ __forceinline__ f32x4 silu4(const f32x4 v) { f32x4 o; for (int e = 0; e < 4; ++e) o[e] = siluf_(v[e]); return o; }
__device__ __forceinline__ f32x4 sigm4(const f32x4 v) { f32x4 o; for (int e = 0; e < 4; ++e) o[e] = sigmoidf_(v[e]); return o; }
__device__ __forceinline__ f32x4 gelu4(const f32x4 v) { f32x4 o; for (int e = 0; e < 4; ++e) o[e] = gelu_tanh(v[e]); return o; }

struct EpiInProj {
    static constexpr bool PERM = true, AFTER_DRAIN = false;
    unsigned char* ws; const float* mgb; const float* subg;
    __device__ __forceinline__ void operator()(const f32x4 (&acc)[2][2][4][2], const Unit& u, int wr, int wc, int fr, int fq) const {
        asm volatile("" : "+v"(fr));
        const int pn = u.pn, row0 = u.pm * BM + wr * 64 + fr;
        if (pn < 4) {
            const float* tab = (const float*)(ws + WS_TAB) + (pn < 2 ? TB_QG : TB_KG);
            bf16_t* dst = (bf16_t*)(ws + WS_Q) + (pn < 2 ? 0 : QKK);
            const int sh = 4 * (pn & 1) + wc, h = sh >> 1, s = sh & 1;
            f32x4 g[2][2];
#pragma unroll
            for (int bj = 0; bj < 2; ++bj)
#pragma unroll
                for (int n = 0; n < 2; ++n) g[bj][n] = *(const f32x4*)(tab + 32 * bj + 8 * fq + 4 * n);
#pragma unroll
            for (int ai = 0; ai < 2; ++ai)
#pragma unroll
                for (int m = 0; m < 4; ++m) { const int row = row0 + ai * HALF + m * 16, b = row >> 12, t = row & 4095; float ss = 0.f;
#pragma unroll
                    for (int bj = 0; bj < 2; ++bj)
#pragma unroll
                        for (int n = 0; n < 2; ++n) { const f32x4 x = acc[ai][bj][m][n]; ss += (x[0] * x[0] + x[1] * x[1]) + (x[2] * x[2] + x[3] * x[3]); }
                    ss += __shfl_xor(ss, 16); ss += __shfl_xor(ss, 32);
                    const float rstd = rsqrtf(ss * (1.0f / 64.0f) + 1e-6f);
#pragma unroll
                    for (int bj = 0; bj < 2; ++bj) { const f32x4 v0 = acc[ai][bj][m][0] * rstd * g[bj][0], v1 = acc[ai][bj][m][1] * rstd * g[bj][1];
                        const size_t base = (size_t)b * QKB + ((((size_t)(h * 2 + s) * 64 + (t >> 6)) * 8 + (4 * bj + fq)) * 64 + (t & 63)) * 8;
                        st16(dst + base, pack8(v0, v1)); } }
        } else if (pn < 6) {
            bf16_t* dst = (bf16_t*)(ws + WS_V);
#pragma unroll
            for (int ai = 0; ai < 2; ++ai)
#pragma unroll
                for (int m = 0; m < 4; ++m) { const int row = row0 + ai * HALF + m * 16, b = row >> 12, t = row & 4095;
#pragma unroll
                    for (int bj = 0; bj < 2; ++bj) { const int h = 2 * (pn - 4) + bj;
                        st16(dst + ((size_t)(b * 4 + h) * SEQ + t) * VD + 32 * wc + 8 * fq, pack8(acc[ai][bj][m][0], acc[ai][bj][m][1])); } }
        } else if (pn < 8 || (pn >= 10 && pn < 12)) {
            bf16_t* dst = (bf16_t*)(ws + (pn < 8 ? WS_GA : WS_GS)); const int colt = 256 * (pn & 1) + 32 * wc + 8 * fq;
            f32x4 sg0 = (f32x4){1.f, 1.f, 1.f, 1.f}, sg1 = sg0;
            if (pn < 8) { sg0 = *(const f32x4*)(subg + 32 * wc + 8 * fq) * (1.0f - LAM_INIT); sg1 = *(const f32x4*)(subg + 32 * wc + 8 * fq + 4) * (1.0f - LAM_INIT); }
#pragma unroll
            for (int ai = 0; ai < 2; ++ai)
#pragma unroll
                for (int m = 0; m < 4; ++m) { const int row = row0 + ai * HALF + m * 16;
#pragma unroll
                    for (int bj = 0; bj < 2; ++bj) st16(dst + (size_t)row * 512 + colt + bj * HALF, pack8(silu4(acc[ai][bj][m][0]) * sg0, silu4(acc[ai][bj][m][1]) * sg1)); }
        } else if (pn < 10) {
            bf16_t* dst = (bf16_t*)(ws + WS_U);
#pragma unroll
            for (int ai = 0; ai < 2; ++ai)
#pragma unroll
                for (int m = 0; m < 4; ++m) { const int row = row0 + ai * HALF + m * 16, b = row >> 12, t = row & 4095;
#pragma unroll
                    for (int bj = 0; bj < 2; ++bj) { const int j = 256 * (pn - 8) + 128 * bj + 32 * wc + 8 * fq, g = j >> 4, hc = j & 15;
                        st16(dst + ((size_t)(b * NG + g) * NCH + (t >> 4)) * ALD + (t & 15) * 16 + hc, pack8(acc[ai][bj][m][0], acc[ai][bj][m][1])); } }
        } else {
            bf16_t* dst = (bf16_t*)(ws + WS_MG); const int ch0 = 128 * (pn - 12) + 32 * wc + 8 * fq;
            f32x4 ba[2], bs[2];
#pragma unroll
            for (int n = 0; n < 2; ++n) { ba[n] = *(const f32x4*)(mgb + ch0 + 4 * n); bs[n] = *(const f32x4*)(mgb + 1024 + ch0 + 4 * n); }
#pragma unroll
            for (int ai = 0; ai < 2; ++ai)
#pragma unroll
                for (int m = 0; m < 4; ++m) { const int row = row0 + ai * HALF + m * 16; f32x4 rr[2], gg[2];
#pragma unroll
                    for (int n = 0; n < 2; ++n) { const f32x4 a = sigm4(acc[ai][0][m][n] + ba[n]); gg[n] = sigm4(acc[ai][1][m][n] + bs[n]);
#pragma unroll
                        for (int e = 0; e < 4; ++e) rr[n][e] = a[e] * __builtin_amdgcn_rcpf(fmaxf(gg[n][e], 1e-30f)); }
                    st16(dst + (size_t)row * 2048 + ch0, pack8(rr[0], rr[1]));
                    st16(dst + (size_t)row * 2048 + 1024 + ch0, pack8(gg[0], gg[1])); }
        }
    }
};
struct EpiGlu {
    static constexpr bool PERM = true, AFTER_DRAIN = false;
    const bf16_t* G; const bf16_t* GS; bf16_t* OS; const float* glub;
    __device__ __forceinline__ void operator()(const f32x4 (&acc)[2][2][4][2], const Unit& u, int wr, int wc, int fr, int fq) const {
        asm volatile("" : "+v"(fr));
        const int row0 = u.pm * BM + wr * 64 + fr, colt = u.pn * BM + 32 * wc + 8 * fq;
        f32x4 bv[2][2];
#pragma unroll
        for (int bj = 0; bj < 2; ++bj)
#pragma unroll
            for (int n = 0; n < 2; ++n) bv[bj][n] = *(const f32x4*)(glub + colt + bj * HALF + 4 * n);
#pragma unroll
        for (int ai = 0; ai < 2; ++ai) { u32x4 gq[4][2], sq[4][2];
#pragma unroll
            for (int m = 0; m < 4; ++m)
#pragma unroll
                for (int bj = 0; bj < 2; ++bj) { const size_t ix = (size_t)(row0 + ai * HALF + m * 16) * 512 + colt + bj * HALF; gq[m][bj] = *(const u32x4*)(G + ix); sq[m][bj] = *(const u32x4*)(GS + ix); }
#pragma unroll
            for (int m = 0; m < 4; ++m) { const size_t ro = (size_t)(row0 + ai * HALF + m * 16) * 512;
#pragma unroll
                for (int bj = 0; bj < 2; ++bj) { f32x4 g0, g1, s0, s1; unpack8(gq[m][bj], g0, g1); unpack8(sq[m][bj], s0, s1);
                    st16(OS + 2 * ro + 512 + colt + bj * HALF, pack8(g0 * sigm4(acc[ai][bj][m][0] + bv[bj][0]) * s0, g1 * sigm4(acc[ai][bj][m][1] + bv[bj][1]) * s1)); } }
            asm volatile("" ::: "memory"); }
    }
};
struct EpiMerge {
    static constexpr bool PERM = true, AFTER_DRAIN = false;
    const bf16_t* MG; bf16_t* MRG;
    __device__ __forceinline__ void mid(f32x4 (&acc)[2][2][4][2], const Unit& u, int wr, int wc, int fr, int fq) const {
        asm volatile("" : "+v"(fr));
        const int row0 = u.pm * BM + wr * 64 + fr, colt = u.pn * BM + 32 * wc + 8 * fq;
#pragma unroll
        for (int ai = 0; ai < 2; ++ai)
#pragma unroll
            for (int m = 0; m < 4; ++m) { const size_t row = (size_t)(row0 + ai * HALF + m * 16);
#pragma unroll
                for (int bj = 0; bj < 2; ++bj) { const int col = colt + bj * HALF; f32x4 r0, r1; unpack8(*(const u32x4*)(MG + row * 2048 + col), r0, r1);
                    acc[ai][bj][m][0] *= r0; acc[ai][bj][m][1] *= r1; } }
    }
    __device__ __forceinline__ void operator()(const f32x4 (&acc)[2][2][4][2], const Unit& u, int wr, int wc, int fr, int fq) const {
        asm volatile("" : "+v"(fr));
        const int row0 = u.pm * BM + wr * 64 + fr, colt = u.pn * BM + 32 * wc + 8 * fq;
        u32x4 gv[2][4][2];
#pragma unroll
        for (int ai = 0; ai < 2; ++ai)
#pragma unroll
            for (int m = 0; m < 4; ++m)
#pragma unroll
                for (int bj = 0; bj < 2; ++bj) gv[ai][m][bj] = *(const u32x4*)(MG + (size_t)(row0 + ai * HALF + m * 16) * 2048 + 1024 + colt + bj * HALF);
#pragma unroll
        for (int ai = 0; ai < 2; ++ai)
#pragma unroll
            for (int m = 0; m < 4; ++m) { const size_t row = (size_t)(row0 + ai * HALF + m * 16);
#pragma unroll
                for (int bj = 0; bj < 2; ++bj) { const int col = colt + bj * HALF; f32x4 s0, s1; unpack8(gv[ai][m][bj], s0, s1);
                    st16(MRG + row * 1024 + col, pack8(s0 * acc[ai][bj][m][0], s1 * acc[ai][bj][m][1])); } }
    }
};
struct EpiOut {
    static constexpr bool PERM = true, AFTER_DRAIN = false;
    const float* x; float* out;
    __device__ __forceinline__ void operator()(const f32x4 (&acc)[2][2][4][2], const Unit& u, int wr, int wc, int fr, int fq) const {
        asm volatile("" : "+v"(fr));
        const int row0 = u.pm * BM + wr * 64 + fr, colt = u.pn * BM + 32 * wc + 8 * fq;
#pragma unroll
        for (int ai = 0; ai < 2; ++ai) { f32x4 xv[4][2][2];
#pragma unroll
            for (int m = 0; m < 4; ++m) { const size_t ro = (size_t)(row0 + ai * HALF + m * 16) * 1024;
#pragma unroll
                for (int bj = 0; bj < 2; ++bj)
#pragma unroll
                    for (int n = 0; n < 2; ++n) xv[m][bj][n] = *(const f32x4*)(x + ro + colt + bj * HALF + 4 * n); }
#pragma unroll
            for (int m = 0; m < 4; ++m) { const size_t ro = (size_t)(row0 + ai * HALF + m * 16) * 1024;
#pragma unroll
                for (int bj = 0; bj < 2; ++bj)
#pragma unroll
                    for (int n = 0; n < 2; ++n) *(f32x4*)(out + ro + colt + bj * HALF + 4 * n) = xv[m][bj][n] + acc[ai][bj][m][n]; }
            asm volatile("" ::: "memory"); }
    }
};
__device__ __forceinline__ int end_lds_idx(int k, int c) { return k * 128 + (c ^ ((k & 7) << 2)); }
struct EpiEnd {
    static constexpr bool PERM = true, AFTER_DRAIN = true;
    __device__ __forceinline__ void fused(f32x4 (&acc)[2][2][4][2], const Unit& u, int wr, int wc, int fr, int fq, PG8_LAS unsigned char* lds, int wid, int lane) const {
        PG8_LAS float* L = (PG8_LAS float*)lds;
#pragma unroll
        for (int ai = 0; ai < 2; ++ai)
#pragma unroll
            for (int m = 0; m < 4; ++m) { const int k = ai * HALF + wr * 64 + m * 16 + fr;
#pragma unroll
                for (int n = 0; n < 2; ++n) *(PG8_LAS f32x4*)(L + end_lds_idx(k, 32 * wc + 8 * fq + 4 * n)) = acc[ai][0][m][n]; }
    }
};
struct EpiY {
    static constexpr bool PERM = true, AFTER_DRAIN = false;
    bf16_t* G;
    __device__ __forceinline__ void operator()(const f32x4 (&acc)[2][2][4][2], const Unit& u, int wr, int wc, int fr, int fq) const {
        int pm_ = u.pm; asm volatile("" : "+s"(pm_), "+v"(fr));
        const int b = pm_ >> 5, g = pm_ & 31;
#pragma unroll
        for (int ai = 0; ai < 2; ++ai)
#pragma unroll
            for (int m = 0; m < 4; ++m) { const int k = ai * HALF + wr * 64 + m * 16 + fr;
#pragma unroll
                for (int bj = 0; bj < 2; ++bj) { const int ct = 128 * bj + 32 * wc + 8 * fq, tt = ct >> 4, hc = ct & 15;
                    st16(G + ((size_t)b * SEQ + 16 * k + tt) * 512 + g * 16 + hc, pack8(gelu4(acc[ai][bj][m][0]), gelu4(acc[ai][bj][m][1]))); }
                asm volatile("" ::: "memory"); }
    }
};
struct OneUnit { Unit u;
    __device__ __forceinline__ bool next(int i, Unit& o) const { if (i != 0) return false; o = u; return true; }
    __device__ __forceinline__ void a_ready(const Unit&) const {}
    __device__ __forceinline__ void done(const Unit&) const {}
};
}
constexpr int NWAVES = 8;
constexpr int RING_OFF = 0, RING_BYTES = 131072;
constexpr int LDSCTL_OFF = RING_BYTES, MISC_OFF = LDSCTL_OFF + 320;
constexpr int LDS_EXTRA_OFF = RING_BYTES + 1024;
constexpr int LDS_BYTES = 147456;
constexpr int CW_TMO = 0, CW_CODE = 1, CW_BAR = 4096, CW_ATTQ = 1024;

constexpr int CW_GBAR = 8192;

struct Args { const float* in[25]; float* out; unsigned char* ws; int ph_lo, ph_hi, li, pad; };

struct Frame {
    LAS unsigned char* lds;
    volatile LAS unsigned* MISC;
    gu32* ctl;
    int tid, lane, wave, vcu, G;
};

__device__ __forceinline__ float wave_sum(float v) {
#pragma unroll
    for (int o = 1; o < 64; o <<= 1) v += __shfl_xor(v, o);
    return v;
}
template <bool MAP> __device__ __forceinline__ void p0_transpose_item(const float* W, int K, int N, bf16* WT, int ldw, LAS float* scr, int item, int lane) {
    const int nblk = N / 32, kb = item / nblk, nb = item % nblk, k0 = 64 * kb, n0 = 32 * nb;
    f32x4 wv[8];
#pragma unroll
    for (int i = 0; i < 8; ++i) wv[i] = *(const GAS f32x4*)(W + (size_t)(k0 + 8 * i + (lane >> 3)) * N + n0 + 4 * (lane & 7));
#pragma unroll
    for (int i = 0; i < 8; ++i) { LAS float* d = scr + (8 * i + (lane >> 3)) * 33 + 4 * (lane & 7); d[0] = wv[i].x; d[1] = wv[i].y; d[2] = wv[i].z; d[3] = wv[i].w; }
    LDS_WAIT(); asm volatile("" ::: "memory");
    const int c = lane & 7;
#pragma unroll
    for (int j = 0; j < 4; ++j) { const int n = (lane >> 3) + 8 * j; const LAS float* s = scr + (8 * c) * 33 + n;
        v4u o; o.x = pk2(s[0 * 33], s[1 * 33]); o.y = pk2(s[2 * 33], s[3 * 33]); o.z = pk2(s[4 * 33], s[5 * 33]); o.w = pk2(s[6 * 33], s[7 * 33]);
        const int dr = MAP ? rowmap_in(n0 + n) : (n0 + n);
        *(GAS v4u*)(WT + (size_t)dr * ldw + k0 + 8 * c) = o; }
    LDS_WAIT(); asm volatile("" ::: "memory");
}
struct XnBatch { f32x4 v[4][4]; };
__device__ __forceinline__ void xn_load(XnBatch& B, int lane, const float* x, int m0, int mstride) {
#pragma unroll
    for (int r = 0; r < 4; ++r) { const GAS f32x4* xr = (const GAS f32x4*)(x + (size_t)(m0 + r * mstride) * DM) + lane;
#pragma unroll
        for (int j = 0; j < 4; ++j) B.v[r][j] = xr[64 * j]; }
}
__device__ __forceinline__ void xn_finish(const XnBatch& B, int lane, const float* gain, bf16* xn, int m0, int mstride) {
    const GAS f32x4* gr = (const GAS f32x4*)gain + lane;
    f32x4 gg[4];
#pragma unroll
    for (int j = 0; j < 4; ++j) gg[j] = gr[64 * j];
#pragma unroll
    for (int r = 0; r < 4; ++r) { float s = 0.f;
#pragma unroll
        for (int j = 0; j < 4; ++j) s += (B.v[r][j].x * B.v[r][j].x + B.v[r][j].y * B.v[r][j].y) + (B.v[r][j].z * B.v[r][j].z + B.v[r][j].w * B.v[r][j].w);
        const float rstd = 1.0f / sqrtf(wave_sum(s) * (1.f / DM) + 1e-6f);
        GAS unsigned long long* o8 = (GAS unsigned long long*)(xn + (size_t)(m0 + r * mstride) * DM) + lane;
#pragma unroll
        for (int j = 0; j < 4; ++j)
            o8[64 * j] = (unsigned long long)pk2(B.v[r][j].x * rstd * gg[j].x, B.v[r][j].y * rstd * gg[j].y) | ((unsigned long long)pk2(B.v[r][j].z * rstd * gg[j].z, B.v[r][j].w * rstd * gg[j].w) << 32); }
}
#define P0_SSM_LDS() LAS float* L = (LAS float*)(F.lds + RING_OFF); LAS float* pwr = L; LAS float* pwi = L + 17 * 64; LAS float* bbr = L + 34 * 64; LAS float* bbi = bbr + 1024; \
    LAS float* cre = bbi + 1024; LAS float* cim = cre + 1024; LAS float* klag = cim + 1024; const int tid = F.tid; unsigned char* ws = args.ws; (void)klag; (void)ws; (void)cim; (void)cre; (void)bbi; (void)bbr; (void)pwi; (void)pwr;
__device__ __forceinline__ void p0_ssm_step1(Frame& F, const Args& args, int g, int q) {
    P0_SSM_LDS()
    if (tid < 64) {
        const int p = tid; const SsmConst sc = ssm_const(args.in[12], args.in[13], args.in[14], g, p);
        double wr = 1.0, wi = 0.0;
        for (int j = 0; j <= 16; ++j) { pwr[j * 64 + p] = (float)wr; pwi[j * 64 + p] = (float)wi; const double nr = wr * sc.lbr - wi * sc.lbi, ni = wr * sc.lbi + wi * sc.lbr; wr = nr; wi = ni; }
        if (q == 0) { float* tab = (float*)(ws + WS_TAB); tab[TB_LB16 + (g * 64 + p) * 2 + 0] = pwr[16 * 64 + p]; tab[TB_LB16 + (g * 64 + p) * 2 + 1] = pwi[16 * 64 + p]; }
        for (int h = 0; h < 16; ++h) { const double br = args.in[15][(g * SP + p) * 16 + h], bi = args.in[16][(g * SP + p) * 16 + h];
            bbr[p * 16 + h] = (float)(sc.qr * br - sc.qi * bi); bbi[p * 16 + h] = (float)(sc.qr * bi + sc.qi * br); }
    }
    for (int i = tid; i < 1024; i += 512) { cre[i] = args.in[17][g * 1024 + i]; cim[i] = args.in[18][g * 1024 + i]; }
}
__device__ __forceinline__ void p0_ssm_klag(Frame& F, const Args& args, int g, int q) {
    P0_SSM_LDS()
    { const int j = tid >> 5, h = (tid >> 1) & 15, oc = tid & 1;
      if (j <= 2 * q + 1) { float s[8] = {0.f, 0.f, 0.f, 0.f, 0.f, 0.f, 0.f, 0.f};
        for (int p = 0; p < 64; ++p) { const float cr = cre[h * 64 + p], ci = cim[h * 64 + p], wr = pwr[j * 64 + p], wi = pwi[j * 64 + p];
            const float er = cr * wr - ci * wi, ei = cr * wi + ci * wr;
#pragma unroll
            for (int e = 0; e < 8; ++e) s[e] += er * bbr[p * 16 + 8 * oc + e] - ei * bbi[p * 16 + 8 * oc + e]; }
#pragma unroll
        for (int e = 0; e < 8; ++e) { const int h2 = 8 * oc + e; klag[(j * 16 + h) * 16 + h2] = s[e] + ((j == 0 && h == h2) ? args.in[19][g * 16 + h] : 0.f); } } }
}
__device__ __forceinline__ void p0_ssm_fill(Frame& F, const Args& args, int g, int q) {
    P0_SSM_LDS()
    bf16* W2 = (bf16*)(ws + WS_W2); bf16* KW = (bf16*)(ws + WS_KW);
    for (int task = tid; task < 32 * 32; task += 512) { const int n = 32 * q + (task >> 5), k8 = task & 31, s = k8 >> 1; float v[8];
#pragma unroll
        for (int e = 0; e < 8; ++e) { const int h2 = 8 * (k8 & 1) + e; float val = 0.f;
            if (n < 128) { const int p = n & 63; const float wr = pwr[(15 - s) * 64 + p], wi = pwi[(15 - s) * 64 + p], br = bbr[p * 16 + h2], bi = bbi[p * 16 + h2];
                val = (n >> 6) ? (wr * bi + wi * br) : (wr * br - wi * bi); }
            v[e] = val; }
        v4u o; o.x = pk2(v[0], v[1]); o.y = pk2(v[2], v[3]); o.z = pk2(v[4], v[5]); o.w = pk2(v[6], v[7]);
        *(GAS v4u*)(W2 + (size_t)(g * 256 + n) * 256 + 8 * k8) = o; }
    for (int task = tid; task < 32 * 48; task += 512) { const int n = 32 * q + task / 48, k8 = task % 48, t = n >> 4, h = n & 15; float v[8];
#pragma unroll
        for (int e = 0; e < 8; ++e) { float val;
            if (k8 < 32) { const int s = k8 >> 1, h2 = 8 * (k8 & 1) + e; val = (s <= t) ? klag[((t - s) * 16 + h) * 16 + h2] : 0.f; }
            else { const int kk = 8 * (k8 - 32) + e, part = kk >> 6, p = kk & 63; const float wr = pwr[(t + 1) * 64 + p], wi = pwi[(t + 1) * 64 + p], cr = cre[h * 64 + p], ci = cim[h * 64 + p];
                val = part ? -(cr * wi + ci * wr) : (cr * wr - ci * wi); }
            v[e] = val; }
        v4u o; o.x = pk2(v[0], v[1]); o.y = pk2(v[2], v[3]); o.z = pk2(v[4], v[5]); o.w = pk2(v[6], v[7]);
        *(GAS v4u*)(KW + (size_t)(g * 256 + n) * ALD + 8 * k8) = o; }
}
__device__ __forceinline__ void p0_attn_tables(Frame& F, const Args& args) {
    LAS float* L = (LAS float*)(F.lds + RING_OFF); float* tab = (float*)(args.ws + WS_TAB); const int tid = F.tid;
    if (tid < 64) {
        float s1 = args.in[6][tid] * args.in[7][tid], s2 = args.in[8][tid] * args.in[9][tid];
        float mq = fabsf(args.in[4][tid]), mk = fabsf(args.in[5][tid]), mt = fmaxf(fabsf(args.in[11][tid]), fabsf(args.in[11][64 + tid]));
#pragma unroll
        for (int o = 1; o < 64; o <<= 1) { s1 += __shfl_xor(s1, o); s2 += __shfl_xor(s2, o); mq = fmaxf(mq, __shfl_xor(mq, o)); mk = fmaxf(mk, __shfl_xor(mk, o)); mt = fmaxf(mt, __shfl_xor(mt, o)); }
        const float m0 = 8.0f * mq * mk + mt;
        if (tid == 0) { tab[TB_LAM] = expf(s1) - expf(s2) + LAM_INIT; tab[TB_M0] = m0; L[0] = m0; }
    }
    __syncthreads();
    const float m0 = L[0];
    if (tid < 4) tab[TB_CFAR + tid] = (args.in[11][15 * 4 + tid] - m0) * LOG2E;
    if (tid < 64) { tab[TB_QG + tid] = args.in[4][tid] * 0.125f * LOG2E; tab[TB_KG + tid] = args.in[5][tid]; }
    for (int i = tid; i < 1024; i += 512) { const int h = i >> 8, idx = i & 255; tab[TB_BIASL + i] = (args.in[11][rel_bucket(idx - 192) * 4 + h] - m0) * LOG2E; }
    __syncthreads();
}
__device__ __forceinline__ void p0_prologue(Frame& F, const Args& args) {
    unsigned char* ws = args.ws;
    const int gw = F.vcu * NWAVES + F.wave, NGW = F.G * NWAVES;
    const int g = F.vcu >> 3, q = F.vcu & 7; const bool ssm = F.vcu < 8 * NG;
    bf16* XN = (bf16*)(ws + WS_XN); const float* x = args.in[0]; const float* gain = args.in[1];
    XnBatch B0, B1;
    int m = gw;
#define XN_HAVE(mm) ((mm) + 3 * NGW < MTOK)
    const bool h0 = XN_HAVE(m), h1 = XN_HAVE(m + 4 * NGW), h2 = XN_HAVE(m + 8 * NGW), h3 = XN_HAVE(m + 12 * NGW);
    if (h0) xn_load(B0, F.lane, x, m, NGW);
    if (h1) xn_load(B1, F.lane, x, m + 4 * NGW, NGW);
    if (ssm) p0_ssm_step1(F, args, g, q);
    __syncthreads();
    if (h0) xn_finish(B0, F.lane, gain, XN, m, NGW);
    if (h2) xn_load(B0, F.lane, x, m + 8 * NGW, NGW);
    if (ssm) p0_ssm_klag(F, args, g, q);
    __syncthreads();
    if (h1) xn_finish(B1, F.lane, gain, XN, m + 4 * NGW, NGW);
    if (h3) xn_load(B1, F.lane, x, m + 12 * NGW, NGW);
    if (ssm) p0_ssm_fill(F, args, g, q);
    __syncthreads();
    if (F.vcu == F.G - 1) p0_attn_tables(F, args);
    if (h2) xn_finish(B0, F.lane, gain, XN, m + 8 * NGW, NGW);
    LAS float* scr = (LAS float*)(F.lds + RING_OFF + F.wave * 16384);
    constexpr int I_IN = (DM / 64) * (NCOL / 32), I_GLU = (SW / 64) * (SW / 32), I_PA = (AW / 64) * (DM / 32), I_PS = (SW / 64) * (DM / 32), I_WO = (DM / 64) * (DM / 32);
    constexpr int NITEMS = I_IN + I_GLU + I_PA + I_PS + I_WO;
    for (int it = gw; it < NITEMS; it += NGW) {
        int r = it;
        if (r < I_IN) { p0_transpose_item<true>(args.in[2], DM, NCOL, (bf16*)(ws + WS_WIN), DM, scr, r, F.lane); }
        else if ((r -= I_IN) < I_GLU) { p0_transpose_item<false>(args.in[20], SW, SW, (bf16*)(ws + WS_GLUW), SW, scr, r, F.lane); }
        else if ((r -= I_GLU) < I_PA) { p0_transpose_item<false>(args.in[22], AW, DM, (bf16*)(ws + WS_PAS), 1024, scr, r, F.lane); }
        else if ((r -= I_PA) < I_PS) { p0_transpose_item<false>(args.in[23], SW, DM, (bf16*)(ws + WS_PAS) + 512, 1024, scr, r, F.lane); }
        else { r -= I_PS; p0_transpose_item<false>(args.in[24], DM, DM, (bf16*)(ws + WS_WOUT), DM, scr, r, F.lane); }
    }
    if (h3) xn_finish(B1, F.lane, gain, XN, m + 12 * NGW, NGW);
    m += 4 * NGW * ((h0 ? 1 : 0) + (h1 ? 1 : 0) + (h2 ? 1 : 0) + (h3 ? 1 : 0));
    while (XN_HAVE(m)) { xn_load(B0, F.lane, x, m, NGW); xn_finish(B0, F.lane, gain, XN, m, NGW); m += 4 * NGW; }
    for (; m < MTOK; m += NGW) { const GAS f32x4* xr = (const GAS f32x4*)(x + (size_t)m * DM) + F.lane; f32x4 v[4]; float s2 = 0.f;
#pragma unroll
        for (int j = 0; j < 4; ++j) { v[j] = xr[64 * j]; s2 += (v[j].x * v[j].x + v[j].y * v[j].y) + (v[j].z * v[j].z + v[j].w * v[j].w); }
        const float rstd = 1.0f / sqrtf(wave_sum(s2) * (1.f / DM) + 1e-6f); const GAS f32x4* gr = (const GAS f32x4*)gain + F.lane; GAS unsigned long long* o8 = (GAS unsigned long long*)(XN + (size_t)m * DM) + F.lane;
#pragma unroll
        for (int j = 0; j < 4; ++j) { const f32x4 gg = gr[64 * j]; o8[64 * j] = (unsigned long long)pk2(v[j].x * rstd * gg.x, v[j].y * rstd * gg.y) | ((unsigned long long)pk2(v[j].z * rstd * gg.z, v[j].w * rstd * gg.w) << 32); } }
#undef XN_HAVE
}
namespace att {
typedef float f32x16 __attribute__((ext_vector_type(16)));
typedef short s16x4 __attribute__((ext_vector_type(4)));
typedef short v4i16_t __attribute__((ext_vector_type(4)));
typedef short bf16x8 __attribute__((ext_vector_type(8)));
typedef unsigned u32x4 __attribute__((ext_vector_type(4)));
typedef float f32x2_t __attribute__((ext_vector_type(2))); typedef __bf16 bf16x2_t __attribute__((ext_vector_type(2)));
typedef __attribute__((address_space(3))) const char* lds_cptr;
typedef __attribute__((address_space(3))) char* lds_ptr;
constexpr int SLOT = 16384, NSLOT = 3;
constexpr int L_K = 0, L_V = NSLOT * SLOT, L_X3 = 2 * NSLOT * SLOT;
__device__ __forceinline__ int x_off(int qg) { return qg == 0 ? 2 * SLOT : qg == 1 ? L_V + SLOT : qg == 2 ? L_V + 2 * SLOT : L_X3; }
constexpr int L_LS = LDS_EXTRA_OFF, L_BIAS = LDS_EXTRA_OFF + 1024;
__device__ __forceinline__ int crow(int r, int hi) { return (r & 3) + 8 * (r >> 2) + 4 * hi; }
__device__ __forceinline__ unsigned cvtpk(float lo, float hi) { f32x2_t v = {lo, hi}; bf16x2_t b = __builtin_convertvector(v, bf16x2_t); return __builtin_bit_cast(unsigned, b); }
__device__ __forceinline__ s16x4 vtr(lds_cptr p) { return __builtin_bit_cast(s16x4, __builtin_amdgcn_ds_read_tr16_b64_v4i16((__attribute__((address_space(3))) v4i16_t*)p)); }
__device__ __forceinline__ void glds16(const void* gsrc, unsigned lds_dst) { unsigned keep;
    asm volatile("s_mov_b32 %0, m0\n\ts_mov_b32 m0, %2\n\ts_nop 0\n\tglobal_load_lds_dwordx4 %1, off\n\ts_mov_b32 m0, %0" : "=&s"(keep) : "v"(gsrc), "s"(lds_dst) : "memory"); }
#define ATT_WAITV(N) asm volatile("s_waitcnt vmcnt(" #N ")" ::: "memory")
#define ATT_BAR() do { asm volatile("s_waitcnt lgkmcnt(0)" ::: "memory"); __builtin_amdgcn_s_barrier(); asm volatile("" ::: "memory"); } while (0)

struct UnitId { int b, h, qb; };
struct UnitSrc { const bf16* ksrc[2]; const bf16* vsrc[2]; const bf16* qp; };
__device__ __forceinline__ UnitSrc unit_src(const UnitId u, unsigned char* ws, int wid, int lane) {
    const bf16* Qg = (const bf16*)(ws + WS_Q) + (size_t)u.b * QKB; const bf16* Kg = Qg + QKK; const bf16* Vg = (const bf16*)(ws + WS_V);
    const int qg = wid & 3, s = wid >> 2, r32 = lane & 31; UnitSrc S;
#pragma unroll
    for (int i = 0; i < 2; ++i) { const int pi = 2 * wid + i, ss = pi >> 3, c = pi & 7, db = pi >> 2, ks = pi & 3;
        S.ksrc[i] = Kg + (size_t)(u.h * 2 + ss) * 64 * 4096 + c * 512 + lane * 8;
        S.vsrc[i] = Vg + ((size_t)(u.b * 4 + u.h) * SEQ + 16 * ks + (lane >> 2)) * VD + 32 * db + (lane & 3) * 8; }
    S.qp = Qg + ((size_t)(u.h * 2 + s) * 64 + (2 * u.qb + (qg >> 1))) * 4096 + (32 * (qg & 1) + r32) * 8;
    return S;
}
__device__ __forceinline__ int attn_unit(const UnitId cu, bool first, bool has_next_s, const UnitId nx_s, unsigned* qcnt, unsigned char* ws, LAS unsigned char* lds, bf16x8 (&qf)[4]) {
    const int b = cu.b, h = cu.h, qb = cu.qb;
    int tid_ = threadIdx.x; asm volatile("" : "+v"(tid_));
    const int tid = tid_, lane = tid & 63, r32 = lane & 31, hi = lane >> 5;
    const int wid = __builtin_amdgcn_readfirstlane(tid >> 6), qg = wid & 3, s = wid >> 2;
    const float* tab = (const float*)(ws + WS_TAB);
#ifdef PROBE_ATT
    const unsigned long long tent_ = __builtin_amdgcn_s_memrealtime();
#endif
    const int NT = 2 * qb + 2;
    const int NTw = 2 * qb + (qg >> 1) + 1;
    const int tq0 = 128 * qb + 32 * qg;
    const UnitSrc US = unit_src(cu, ws, wid, lane);
    int kdst[2], vdst[2];
#pragma unroll
    for (int i = 0; i < 2; ++i) { const int pi = 2 * wid + i; kdst[i] = L_K + (pi >> 3) * 8192 + (pi & 7) * 1024; vdst[i] = L_V + ((pi >> 2) * 4 + (pi & 3)) * 1024; }
    const unsigned lds0 = (unsigned)(size_t)lds;
#define ATT_DMAK_(src, t, slot) do { _Pragma("unroll") for (int i_ = 0; i_ < 2; ++i_) \
        glds16((src).ksrc[i_] + (size_t)(t) * 4096, (unsigned)__builtin_amdgcn_readfirstlane((int)(lds0 + kdst[i_] + (slot) * SLOT))); } while (0)
#define ATT_DMAV_(src, t, slot) do { _Pragma("unroll") for (int i_ = 0; i_ < 2; ++i_) \
        glds16((src).vsrc[i_] + (size_t)(t) * 64 * VD, (unsigned)__builtin_amdgcn_readfirstlane((int)(lds0 + vdst[i_] + (slot) * SLOT))); } while (0)
#define ATT_DMAK(t, slot) ATT_DMAK_(US, t, slot)
#define ATT_DMAV(t, slot) ATT_DMAV_(US, t, slot)
#define ATT_QLOAD(src) do { _Pragma("unroll") for (int d0 = 0; d0 < 4; ++d0) qf[d0] = *(const bf16x8*)((src).qp + (2 * d0 + hi) * 512); } while (0)
    if (first) {
        ATT_DMAK(0, 0); ATT_DMAK(1, 1); ATT_DMAV(0, 0);
        ATT_QLOAD(US);
        if (tid < 256) ((LAS float*)(lds + L_BIAS))[tid] = tab[TB_BIASL + h * 256 + tid] - tab[TB_CFAR + h];
    }
    const float cfar = tab[TB_CFAR + h], lam = tab[TB_LAM];
    asm volatile("" :: "v"(cfar), "v"(lam), "v"(qf[0]), "v"(qf[1]), "v"(qf[2]), "v"(qf[3]));
    f32x16 o[4];
#pragma unroll
    for (int d = 0; d < 4; ++d) o[d] = (f32x16){0.f, 0.f, 0.f, 0.f, 0.f, 0.f, 0.f, 0.f, 0.f, 0.f, 0.f, 0.f, 0.f, 0.f, 0.f, 0.f};
    f32x16 lacc = (f32x16){0.f, 0.f, 0.f, 0.f, 0.f, 0.f, 0.f, 0.f, 0.f, 0.f, 0.f, 0.f, 0.f, 0.f, 0.f, 0.f};
    const bf16x8 ones = (bf16x8){0x3F80, 0x3F80, 0x3F80, 0x3F80, 0x3F80, 0x3F80, 0x3F80, 0x3F80};
    const lds_cptr kbase = (lds_cptr)lds + L_K + s * 8192 + hi * 1024 + r32 * 16;
    const lds_cptr vbase = (lds_cptr)lds + L_V + ((lane >> 4) & 1) * 32 + (lane & 3) * 8 + (4 * hi + ((lane & 15) >> 2)) * 64;
    f32x16 cfv;
#pragma unroll
    for (int r = 0; r < 16; ++r) cfv[r] = cfar;
    asm volatile("" : "+v"(cfv));
    u32x4 pw[4];
    f32x16 p0, p1;
    int slot = 0, pslot = 0;
#define ATT_SB() __builtin_amdgcn_sched_barrier(0)
#define ATT_VF(i) ({ const s16x4 lo_ = vtr(vp + (i) * 1024), hh_ = vtr(vp + (i) * 1024 + 512); (bf16x8){lo_[0], lo_[1], lo_[2], lo_[3], hh_[0], hh_[1], hh_[2], hh_[3]}; })
#define ATT_KLOAD() do { const lds_cptr kp = kbase + slot * SLOT; \
        _Pragma("unroll") for (int d0 = 0; d0 < 4; ++d0) { kf[2 * d0] = *(const __attribute__((address_space(3))) bf16x8*)(kp + d0 * 2048); \
                                                         kf[2 * d0 + 1] = *(const __attribute__((address_space(3))) bf16x8*)(kp + d0 * 2048 + 512); } } while (0)
#define ATT_QK(cv_) do { \
        p0 = __builtin_amdgcn_mfma_f32_32x32x16_bf16(kf[0], qf[0], (cv_), 0, 0, 0); \
        p1 = __builtin_amdgcn_mfma_f32_32x32x16_bf16(kf[1], qf[0], (cv_), 0, 0, 0); \
        _Pragma("unroll") for (int d0 = 1; d0 < 4; ++d0) { \
            p0 = __builtin_amdgcn_mfma_f32_32x32x16_bf16(kf[2 * d0], qf[d0], p0, 0, 0, 0); \
            p1 = __builtin_amdgcn_mfma_f32_32x32x16_bf16(kf[2 * d0 + 1], qf[d0], p1, 0, 0, 0); } } while (0)
#define ATT_NEARBIAS(t_) do { const LAS float* bt = (const LAS float*)(lds + L_BIAS) + (64 * (t_) - tq0 - r32 + 192); \
        _Pragma("unroll") for (int r = 0; r < 16; ++r) { p0[r] += bt[crow(r, hi)]; p1[r] += bt[crow(r, hi) + 32]; } } while (0)
#define ATT_PACK() do { _Pragma("unroll") for (int j = 0; j < 4; ++j) { pw[0][j] = cvtpk(p0[2 * j], p0[2 * j + 1]); pw[1][j] = cvtpk(p0[8 + 2 * j], p0[8 + 2 * j + 1]); \
                                          pw[2][j] = cvtpk(p1[2 * j], p1[2 * j + 1]); pw[3][j] = cvtpk(p1[8 + 2 * j], p1[8 + 2 * j + 1]); } } while (0)
#ifdef PROBE_ATT
    unsigned long long tseg_[7]; tseg_[1] = __builtin_amdgcn_s_memrealtime();
#define ATT_TS(i) do { tseg_[i] = __builtin_amdgcn_s_memrealtime(); } while (0)
#else
#define ATT_TS(i) do {} while (0)
#endif
    volatile LAS unsigned* qw = (volatile LAS unsigned*)(lds + MISC_OFF) + 13;
    for (int t = 0; t <= NT; ++t) {
        if (qcnt && t == NT - 1 && tid == 0) *qw = __hip_atomic_fetch_add(qcnt, 1u, __ATOMIC_RELAXED, __HIP_MEMORY_SCOPE_AGENT);
        if (t == 0 || t + 1 < NT) ATT_WAITV(4); else if (t < NT) ATT_WAITV(2); else ATT_WAITV(0);
        ATT_BAR();
        if (t + 2 < NT) { const int s2 = (slot + 2 >= NSLOT) ? slot + 2 - NSLOT : slot + 2; ATT_DMAK(t + 2, s2); }
        if (t + 1 < NT) { const int s1 = (slot + 1 >= NSLOT) ? slot + 1 - NSLOT : slot + 1; ATT_DMAV(t + 1, s1); }
        const lds_cptr vp = vbase + pslot * SLOT;
        if (t >= 1 && t < NTw) {
            const bool nearT = (t + 3 >= NTw);
            bf16x8 kf[8], vfr[4];
            ATT_KLOAD();
            vfr[0] = ATT_VF(0); vfr[1] = ATT_VF(1); vfr[2] = ATT_VF(2);
            ATT_SB();
            ATT_QK(cfv);
            if (nearT) ATT_NEARBIAS(t);
            ATT_SB();
#pragma unroll
            for (int i = 0; i < 16; ++i) {
                o[i >> 2] = __builtin_amdgcn_mfma_f32_32x32x16_bf16(__builtin_bit_cast(bf16x8, pw[i & 3]), vfr[i & 3], o[i >> 2], 0, 0, 0);
                if (i < 4) lacc = __builtin_amdgcn_mfma_f32_32x32x16_bf16(__builtin_bit_cast(bf16x8, pw[i]), ones, lacc, 0, 0, 0);
                if (i + 3 < 16) vfr[(i + 3) & 3] = ATT_VF(i + 3);
                p0[i] = __builtin_amdgcn_exp2f(p0[i]); p1[i] = __builtin_amdgcn_exp2f(p1[i]);
                ATT_SB();
            }
            ATT_PACK();
        } else if (t == 0) {
            const bool nearT = (t + 3 >= NTw);
            bf16x8 kf[8]; ATT_KLOAD();
            ATT_QK(cfv);
            if (nearT) ATT_NEARBIAS(t);
#pragma unroll
            for (int r = 0; r < 16; ++r) { p0[r] = __builtin_amdgcn_exp2f(p0[r]); p1[r] = __builtin_amdgcn_exp2f(p1[r]); }
            ATT_PACK();
        } else if (t == NTw) {
#pragma unroll
            for (int i = 0; i < 16; ++i) { const bf16x8 vf = ATT_VF(i);
                o[i >> 2] = __builtin_amdgcn_mfma_f32_32x32x16_bf16(__builtin_bit_cast(bf16x8, pw[i & 3]), vf, o[i >> 2], 0, 0, 0);
                if (i < 4) lacc = __builtin_amdgcn_mfma_f32_32x32x16_bf16(__builtin_bit_cast(bf16x8, pw[i]), ones, lacc, 0, 0, 0); }
        }
        pslot = slot; slot = (slot + 1 == NSLOT) ? 0 : slot + 1;
    }
#undef ATT_SB
#undef ATT_VF
#undef ATT_QK
#undef ATT_KLOAD
#undef ATT_NEARBIAS
#undef ATT_PACK
    ATT_TS(2);
    ATT_BAR();
    ATT_TS(3);
    int nq = 64; bool has_next = has_next_s; UnitId nx = nx_s;
    if (qcnt) { nq = (int)*qw; has_next = nq < 32; nx.b = b; nx.h = h; nx.qb = has_next ? 31 - nq : qb; }
    const int row = lane >> 2, quar = lane & 3;
    const int rbase = (s == 0) ? 16 : 0;
    const size_t tok = (size_t)b * SEQ + tq0 + rbase + row;
    u32x4 gav[4];
    { const bf16* ga = (const bf16*)(ws + WS_GA) + tok * 512 + h * 128 + quar * 32;
#pragma unroll
      for (int j = 0; j < 4; ++j) gav[j] = *(const u32x4*)(ga + j * 8); }
    if (has_next) {
        const UnitSrc NS = unit_src(nx, ws, wid, lane);
        ATT_DMAK_(NS, 0, 0); ATT_DMAK_(NS, 1, 1); ATT_DMAV_(NS, 0, 0);
        if (nx.h != h && tid < 256) ((LAS float*)(lds + L_BIAS))[tid] = tab[TB_BIASL + nx.h * 256 + tid] - tab[TB_CFAR + nx.h];
    }
    const float sc = (s == 1) ? lam : 1.0f;
#pragma unroll
    for (int r = 0; r < 16; ++r) { const float f = sc * __builtin_amdgcn_rcpf(lacc[r]);
#pragma unroll
        for (int db = 0; db < 4; ++db) o[db][r] *= f; }
    LAS float* XW = (LAS float*)(lds + x_off(qg)) + (s == 0 ? 0 : 2048);
    LAS float* XR = (LAS float*)(lds + x_off(qg)) + (s == 0 ? 2048 : 0);
    if (s == 0) {
#pragma unroll
        for (int db = 0; db < 4; ++db)
#pragma unroll
            for (int r = 0; r < 8; ++r) XW[(db * 8 + r) * 64 + lane] = o[db][r];
    } else {
#pragma unroll
        for (int db = 0; db < 4; ++db)
#pragma unroll
            for (int r = 0; r < 8; ++r) XW[(db * 8 + r) * 64 + lane] = o[db][8 + r];
    }
    ATT_BAR();
    ATT_TS(4);
    float v[4][8];
    if (s == 0) {
#pragma unroll
        for (int db = 0; db < 4; ++db)
#pragma unroll
            for (int r = 0; r < 8; ++r) v[db][r] = o[db][8 + r] - XR[(db * 8 + r) * 64 + lane];
    } else {
#pragma unroll
        for (int db = 0; db < 4; ++db)
#pragma unroll
            for (int r = 0; r < 8; ++r) v[db][r] = XR[(db * 8 + r) * 64 + lane] - o[db][r];
    }
    asm volatile("s_waitcnt lgkmcnt(0)" ::: "memory");
    LAS bf16* stg = (LAS bf16*)XR;
#pragma unroll
    for (int db = 0; db < 4; ++db)
#pragma unroll
        for (int r = 0; r < 8; ++r) { const float x_ = v[db][r]; stg[crow(r, hi) * 128 + 32 * db + r32] = (bf16)(cvtpk(x_, x_) & 0xffffu); }
    asm volatile("s_waitcnt lgkmcnt(0)" ::: "memory");
    { u32x4 w[4]; float ss = 0.f;
#pragma unroll
      for (int j = 0; j < 4; ++j) { w[j] = *(const LAS u32x4*)(stg + row * 128 + quar * 32 + j * 8);
          pg8::f32x4 a, c; pg8::unpack8(w[j], a, c); ss += (a[0] * a[0] + a[1] * a[1]) + (a[2] * a[2] + a[3] * a[3]) + (c[0] * c[0] + c[1] * c[1]) + (c[2] * c[2] + c[3] * c[3]); }
      ss += __shfl_xor(ss, 1); ss += __shfl_xor(ss, 2);
      const float rstd = rsqrtf(ss * (1.0f / 128.0f) + 1e-6f);
      bf16* oa = (bf16*)(ws + WS_OAS) + tok * 1024 + h * 128 + quar * 32;
#pragma unroll
      for (int j = 0; j < 4; ++j) { pg8::f32x4 a, c, g0, g1; pg8::unpack8(w[j], a, c); pg8::unpack8(gav[j], g0, g1);
          *(u32x4*)(oa + j * 8) = pg8::pack8(a * rstd * g0, c * rstd * g1); } }
    ATT_TS(5);
    if (has_next) { const UnitSrc NS = unit_src(nx, ws, wid, lane); ATT_QLOAD(NS); }
    ATT_BAR();
    ATT_TS(6);
#ifdef PROBE_ATT
    tseg_[0] = tent_;
    if (tid == 0) { volatile LAS unsigned* mm = (volatile LAS unsigned*)(lds + MISC_OFF); const unsigned long long d_ = tseg_[PROBE_ATT + 1] - tseg_[PROBE_ATT]; const unsigned long long acc_ = (((unsigned long long)mm[25] << 32) | mm[24]) + d_; mm[24] = (unsigned)acc_; mm[25] = (unsigned)(acc_ >> 32); }
#endif
    return nq;
#undef ATT_DMAK_
#undef ATT_DMAV_
#undef ATT_QLOAD
#undef ATT_DMAK
#undef ATT_DMAV
}
__device__ __forceinline__ void phase_attn_body(int vcu, int G, unsigned char* ws, LAS unsigned char* lds) {
    bf16x8 qf[4];
#if 1
    if (__builtin_amdgcn_readfirstlane(threadIdx.x) >= 256) __builtin_amdgcn_s_setprio(1);
#endif
    if (G == 256) {
        const int bh = vcu >> 3, s8 = vcu & 7;
#define ATT_QB(i) ((i) == 0 ? 31 - s8 : (i) == 1 ? 16 + s8 : (i) == 2 ? 15 - s8 : s8)
#pragma unroll 1
        for (int i = 0; i < 4; ++i) { const UnitId c{bh >> 2, bh & 3, ATT_QB(i)}; const UnitId n{bh >> 2, bh & 3, ATT_QB(i < 3 ? i + 1 : 3)}; (void)attn_unit(c, i == 0, i < 3, n, nullptr, ws, lds, qf); }
#undef ATT_QB
    } else {
        bool first = true;
#pragma unroll 1
        for (int uu = vcu; uu < BATCH * NH * 32; uu += G) { const UnitId c{uu >> 7, (uu >> 5) & 3, 31 - (uu & 31)}; const int nn = uu + G; const bool hn = nn < BATCH * NH * 32;
            const UnitId n{hn ? nn >> 7 : c.b, hn ? (nn >> 5) & 3 : c.h, hn ? 31 - (nn & 31) : c.qb}; (void)attn_unit(c, first, hn, n, nullptr, ws, lds, qf); first = false; }
    }
#if 1
    __builtin_amdgcn_s_setprio(0);
#endif
}
#undef ATT_WAITV
#undef ATT_BAR
}
#ifndef PG8_SP2
#define PG8_SP2 true
#endif
#ifndef PG8_ALIGN
#define PG8_ALIGN true
#endif
#ifndef ALIGN_P1
#define ALIGN_P1 true
#endif
#ifndef ALIGN_P5
#define ALIGN_P5 true
#endif
#ifndef ALIGN_P6
#define ALIGN_P6 true
#endif
__device__ __forceinline__ void phase_attn(Frame& F, const Args& args, char*) { att::phase_attn_body(F.vcu, F.G, args.ws, F.lds); }
__device__ __forceinline__ void phase_inproj(Frame& F, const Args& args) {
    unsigned char* ws = args.ws;
    pg8::Gemm g{(const bf16*)(ws + WS_XN), (const bf16*)(ws + WS_WIN), MTOK, NCOL, DM, DM, DM};
    pg8::StaticOrder S; S.init(MTOK, NCOL, F.G, (int)blockIdx.x);
    pg8::EpiInProj E{ws, args.in[3], args.in[10]};
    pg8::gemm_phase<pg8::EpiInProj, pg8::StaticOrder, ALIGN_P1, PG8_SP2>(F.lds + RING_OFF, g, S, E);
}
__device__ __forceinline__ void phase_ssm(Frame& F, const Args& args) {
    unsigned char* ws = args.ws;
    { const int L = F.vcu; if (L < BATCH * NG) {
        const int gg = L & 31, b = L >> 5, bg = b * NG + gg;
        pg8::OneUnit S{{bg, gg}};
        { pg8::Gemm g{(const bf16*)(ws + WS_U), (const bf16*)(ws + WS_W2), BATCH * NG * NCH, NG * 256, 256, ALD, 256};
          pg8::EpiEnd E{};
          pg8::gemm_phase<pg8::EpiEnd, pg8::OneUnit, false, PG8_SP2>(F.lds + RING_OFF, g, S, E); }
        LDS_WAIT(); __syncthreads();
        {
            const int p = F.lane, w = F.wave; const float* tab = (const float*)(ws + WS_TAB);
            const float ar = tab[TB_LB16 + (gg * 64 + p) * 2], ai = tab[TB_LB16 + (gg * 64 + p) * 2 + 1];
            const LAS float* END = (const LAS float*)(F.lds + RING_OFF);
            LAS float* EX = (LAS float*)(F.lds + LDS_EXTRA_OFF);
            float pr[32], pi[32]; float cr = 0.f, ci = 0.f;
#pragma unroll
            for (int j = 0; j < 32; ++j) { const int k = 32 * w + j; const float er = END[pg8::end_lds_idx(k, p)], ei = END[pg8::end_lds_idx(k, 64 + p)];
                pr[j] = cr; pi[j] = ci; const float nr = ar * cr - ai * ci + er, ni = ar * ci + ai * cr + ei; cr = nr; ci = ni; }
            EX[(w * 2 + 0) * 64 + p] = cr; EX[(w * 2 + 1) * 64 + p] = ci;
            float qr = ar, qi = ai;
#pragma unroll
            for (int i = 0; i < 5; ++i) { const float nr = qr * qr - qi * qi, ni = 2.f * qr * qi; qr = nr; qi = ni; }
            LDS_WAIT(); __syncthreads();
            float sr = 0.f, si = 0.f;
            for (int v = 0; v < w; ++v) { const float er = EX[(v * 2 + 0) * 64 + p], ei = EX[(v * 2 + 1) * 64 + p]; const float nr = qr * sr - qi * si + er, ni = qr * si + qi * sr + ei; sr = nr; si = ni; }
            bf16* A = (bf16*)(ws + WS_U) + ((size_t)bg * NCH + 32 * w) * ALD + 256;
            float zr = sr, zi = si;
#pragma unroll
            for (int j = 0; j < 32; ++j) { A[j * ALD + p] = (bf16)f2bf(pr[j] + zr); A[j * ALD + 64 + p] = (bf16)f2bf(pi[j] + zi);
                const float nr = ar * zr - ai * zi, ni = ar * zi + ai * zr; zr = nr; zi = ni; }
        }
        VM_WAIT(); LDS_WAIT(); __syncthreads();
        { pg8::Gemm g{(const bf16*)(ws + WS_U), (const bf16*)(ws + WS_KW), BATCH * NG * NCH, NG * 256, ALD, ALD, ALD};
          pg8::EpiY E{(bf16*)(ws + WS_G)};
          pg8::gemm_phase<pg8::EpiY, pg8::OneUnit, false, PG8_SP2>(F.lds + RING_OFF, g, S, E); }
    } }
}
__device__ __forceinline__ void phase_glu_t1(Frame& F, const Args& args) {
    unsigned char* ws = args.ws;
    pg8::Gemm g{(const bf16*)(ws + WS_G), (const bf16*)(ws + WS_GLUW), MTOK, SW, SW, SW, SW};
    pg8::StaticOrder S; S.init(MTOK, SW, F.G, (int)blockIdx.x);
    pg8::EpiGlu E{(const bf16*)(ws + WS_G), (const bf16*)(ws + WS_GS), (bf16*)(ws + WS_OAS), args.in[21]};
    pg8::gemm_phase<pg8::EpiGlu, pg8::StaticOrder, PG8_ALIGN, PG8_SP2>(F.lds + RING_OFF, g, S, E);
}
__device__ __forceinline__ void phase_merge(Frame& F, const Args& args) {
    unsigned char* ws = args.ws;
    pg8::Gemm g{(const bf16*)(ws + WS_OAS), (const bf16*)(ws + WS_PAS), MTOK, DM, DM, DM, DM};
    pg8::StaticOrder S; S.init(MTOK, DM, F.G, (int)blockIdx.x);
    pg8::EpiMerge E{(const bf16*)(ws + WS_MG), (bf16*)(ws + WS_MRG)};
    pg8::gemm_phase<pg8::EpiMerge, pg8::StaticOrder, ALIGN_P5, PG8_SP2, 512>(F.lds + RING_OFF, g, S, E);
}
__device__ __forceinline__ void phase_out(Frame& F, const Args& args) {
    unsigned char* ws = args.ws;
    pg8::Gemm g{(const bf16*)(ws + WS_MRG), (const bf16*)(ws + WS_WOUT), MTOK, DM, DM, DM, DM};
    pg8::StaticOrder S; S.init(MTOK, DM, F.G, (int)blockIdx.x);
    pg8::EpiOut E{args.in[0], args.out};
    pg8::gemm_phase<pg8::EpiOut, pg8::StaticOrder, ALIGN_P6, PG8_SP2>(F.lds + RING_OFF, g, S, E);
}
#if USE_NAIVE
struct NArgs { const float* in[25]; float* out; unsigned char* ws; };
__device__ __forceinline__ void st_bf(bf16* p, size_t i, float v) { p[i] = (bf16)f2bf(v); }

template <int MODE> __global__ void __launch_bounds__(256) nk_gemm(NArgs a) {
    __shared__ float As[16][65], Bs[16][65], red[64][17];
    unsigned char* ws = a.ws; const float* tab = (const float*)(ws + WS_TAB);
    const bf16* A; const bf16* Bt; int K, lda;
    if (MODE == 1) { A = (const bf16*)(ws + WS_XN); Bt = (const bf16*)(ws + WS_WIN); K = 1024; lda = 1024; }
    else if (MODE == 3) { A = (const bf16*)(ws + WS_G); Bt = (const bf16*)(ws + WS_GLUW); K = 512; lda = 512; }
    else if (MODE == 4) { A = (const bf16*)(ws + WS_OA); Bt = (const bf16*)(ws + WS_PA); K = 512; lda = 512; }
    else if (MODE == 5) { A = (const bf16*)(ws + WS_OS); Bt = (const bf16*)(ws + WS_PS); K = 512; lda = 512; }
    else { A = (const bf16*)(ws + WS_T1); Bt = (const bf16*)(ws + WS_WOUT); K = 1024; lda = 1024; }
    const int tid = threadIdx.x, ty = tid >> 4, tx = tid & 15, m0 = blockIdx.y * 64, n0 = blockIdx.x * 64;
    float acc[4][4] = {};
    for (int k0 = 0; k0 < K; k0 += 16) {
        for (int i = tid; i < 1024; i += 256) { const int r = i >> 4, kk = i & 15;
            As[kk][r] = bf2f(A[(size_t)(m0 + r) * lda + k0 + kk]);
            const int n = n0 + r; const int br = (MODE == 1) ? rowmap_in(n) : n;
            Bs[kk][r] = bf2f(Bt[(size_t)br * K + k0 + kk]); }
        __syncthreads();
#pragma unroll
        for (int kk = 0; kk < 16; ++kk) { float av[4], bv[4];
#pragma unroll
            for (int i = 0; i < 4; ++i) { av[i] = As[kk][ty * 4 + i]; bv[i] = Bs[kk][tx * 4 + i]; }
#pragma unroll
            for (int i = 0; i < 4; ++i)
#pragma unroll
                for (int j = 0; j < 4; ++j) acc[i][j] += av[i] * bv[j]; }
        __syncthreads();
    }
    if (MODE == 1) {
        const int typ = n0 < 512 ? 0 : n0 < 1024 ? 1 : n0 < 1536 ? 2 : n0 < 2048 ? 3 : n0 < 2560 ? 4 : n0 < 3072 ? 5 : 6;
        float rstd[4] = {1.f, 1.f, 1.f, 1.f};
        if (typ <= 1) {
            for (int i = 0; i < 4; ++i) { float s = 0.f; for (int j = 0; j < 4; ++j) s += acc[i][j] * acc[i][j]; red[ty * 4 + i][tx] = s; }
            __syncthreads();
            for (int i = 0; i < 4; ++i) { float s = 0.f; for (int j = 0; j < 16; ++j) s += red[ty * 4 + i][j]; rstd[i] = rsqrtf(s * (1.0f / 64.0f) + 1e-6f); }
        }
        for (int i = 0; i < 4; ++i) { const int row = m0 + ty * 4 + i, b = row >> 12, t = row & 4095;
            for (int j = 0; j < 4; ++j) { const int n = n0 + tx * 4 + j; const float v = acc[i][j];
                if (typ == 0) { const int sh = n >> 6, d = n & 63; st_bf((bf16*)(ws + WS_Q), qk_index(b, sh >> 1, sh & 1, t, d), v * rstd[i] * tab[TB_QG + d]); }
                else if (typ == 1) { const int sh = (n - 512) >> 6, d = n & 63; st_bf((bf16*)(ws + WS_K), qk_index(b, sh >> 1, sh & 1, t, d), v * rstd[i] * tab[TB_KG + d]); }
                else if (typ == 2) { const int c = n - 1024; st_bf((bf16*)(ws + WS_V), v_index(b, c >> 7, t, c & 127), v); }
                else if (typ == 3) { st_bf((bf16*)(ws + WS_GA), (size_t)row * 512 + (n - 1536), siluf_(v)); }
                else if (typ == 4) { const int c = n - 2048; st_bf((bf16*)(ws + WS_U), u_index(b, c >> 4, t, c & 15), v); }
                else if (typ == 5) { st_bf((bf16*)(ws + WS_GS), (size_t)row * 512 + (n - 2560), siluf_(v)); }
                else { const int c = n - 3072; st_bf((bf16*)(ws + WS_MG), (size_t)row * 2048 + c, sigmoidf_(v + a.in[3][c])); } } }
    } else {
        for (int i = 0; i < 4; ++i) { const int row = m0 + ty * 4 + i;
            for (int j = 0; j < 4; ++j) { const int n = n0 + tx * 4 + j; const float v = acc[i][j];
                if (MODE == 3) { const float g = bf2f(((const bf16*)(ws + WS_G))[(size_t)row * 512 + n]); const float gs = bf2f(((const bf16*)(ws + WS_GS))[(size_t)row * 512 + n]);
                    st_bf((bf16*)(ws + WS_OS), (size_t)row * 512 + n, g * sigmoidf_(v + a.in[21][n]) * gs); }
                else if (MODE == 4) { const float ga = bf2f(((const bf16*)(ws + WS_MG))[(size_t)row * 2048 + n]); st_bf((bf16*)(ws + WS_T1), (size_t)row * 1024 + n, ga * v); }
                else if (MODE == 5) { const float gs = bf2f(((const bf16*)(ws + WS_MG))[(size_t)row * 2048 + 1024 + n]); bf16* T1 = (bf16*)(ws + WS_T1); const size_t ix = (size_t)row * 1024 + n; st_bf(T1, ix, bf2f(T1[ix]) + gs * v); }
                else { const size_t ix = (size_t)row * 1024 + n; a.out[ix] = a.in[0][ix] + v; } } }
    }
}

__global__ void __launch_bounds__(256) nk_attn(NArgs a) {
    __shared__ float Qs[2][16][64], Ps[2][16][65];
    unsigned char* ws = a.ws; const float* tab = (const float*)(ws + WS_TAB);
    const bf16* Q = (const bf16*)(ws + WS_Q); const bf16* Kb = (const bf16*)(ws + WS_K); const bf16* V = (const bf16*)(ws + WS_V);
    const int tid = threadIdx.x, ql = tid >> 4, part = tid & 15, q0 = blockIdx.x * 16, h = blockIdx.y, b = blockIdx.z;
    const float m0 = tab[TB_M0], lam = tab[TB_LAM];
    for (int i = tid; i < 2048; i += 256) { const int s = i >> 10, q = (i >> 6) & 15, d = i & 63; Qs[s][q][d] = bf2f(Q[qk_index(b, h, s, q0 + q, d)]); }
    __syncthreads();
    const int ntile = (q0 >> 6) + 1;
    float o[2][8] = {}; float lacc[2] = {0.f, 0.f};
    for (int kt = 0; kt < ntile; ++kt) {
        for (int i = tid; i < 2048; i += 256) { const int s = i >> 10, q = (i >> 6) & 15, k = i & 63, key = kt * 64 + k;
            float dot = 0.f; for (int d = 0; d < 64; ++d) dot += Qs[s][q][d] * bf2f(Kb[qk_index(b, h, s, key, d)]);
            const float bias = (a.in[11][rel_bucket(key - (q0 + q)) * 4 + h] - m0) * LOG2E;
            Ps[s][q][k] = exp2f(dot + bias); }
        __syncthreads();
        for (int s = 0; s < 2; ++s) {
            for (int k = part * 4; k < part * 4 + 4; ++k) lacc[s] += Ps[s][ql][k];
            for (int k = 0; k < 64; ++k) { const float p = Ps[s][ql][k]; const bf16* vr = V + v_index(b, h, kt * 64 + k, part * 8);
                for (int j = 0; j < 8; ++j) o[s][j] += p * bf2f(vr[j]); } }
        __syncthreads();
    }
    for (int s = 0; s < 2; ++s) for (int off = 1; off < 16; off <<= 1) lacc[s] += __shfl_xor(lacc[s], off);
    float ov[8], ss = 0.f;
    for (int j = 0; j < 8; ++j) { ov[j] = o[0][j] / lacc[0] - lam * o[1][j] / lacc[1]; ss += ov[j] * ov[j]; }
    for (int off = 1; off < 16; off <<= 1) ss += __shfl_xor(ss, off);
    const float rstd = rsqrtf(ss * (1.0f / 128.0f) + 1e-6f);
    const size_t row = (size_t)b * SEQ + q0 + ql;
    for (int j = 0; j < 8; ++j) { const int dv = part * 8 + j; const float ga = bf2f(((const bf16*)(ws + WS_GA))[row * 512 + h * 128 + dv]);
        st_bf((bf16*)(ws + WS_OA), row * 512 + h * 128 + dv, ov[j] * rstd * a.in[10][dv] * (1.0f - LAM_INIT) * ga); }
}

__global__ void __launch_bounds__(64) nk_ssm(NArgs a) {
    __shared__ float X[64][129], Us[64][16], cre[16][64], cim[16][64], bbr[64][17], bbi[64][17];
    unsigned char* ws = a.ws; const bf16* U = (const bf16*)(ws + WS_U); bf16* G = (bf16*)(ws + WS_G);
    const int p = threadIdx.x, bg = blockIdx.x, b = bg >> 5, g = bg & 31;
    const SsmConst sc = ssm_const(a.in[12], a.in[13], a.in[14], g, p);
    for (int h = 0; h < 16; ++h) { const double br = a.in[15][(g * SP + p) * 16 + h], bi = a.in[16][(g * SP + p) * 16 + h]; bbr[p][h] = (float)(sc.qr * br - sc.qi * bi); bbi[p][h] = (float)(sc.qr * bi + sc.qi * br); }
    for (int i = p; i < 1024; i += 64) { cre[i >> 6][i & 63] = a.in[17][g * 1024 + i]; cim[i >> 6][i & 63] = a.in[18][g * 1024 + i]; }
    const float lbr = (float)sc.lbr, lbi = (float)sc.lbi; float xr = 0.f, xi = 0.f;
    for (int c0 = 0; c0 < SEQ; c0 += 64) {
        __syncthreads();
        for (int i = p; i < 1024; i += 64) Us[i >> 4][i & 15] = bf2f(U[u_index(b, g, c0 + (i >> 4), i & 15)]);
        __syncthreads();
#pragma unroll 1
        for (int tt = 0; tt < 64; ++tt) { float br = 0.f, bi = 0.f;
#pragma unroll 4
            for (int h = 0; h < 16; ++h) { br += bbr[p][h] * Us[tt][h]; bi += bbi[p][h] * Us[tt][h]; }
            const float nr = lbr * xr - lbi * xi + br, ni = lbr * xi + lbi * xr + bi; xr = nr; xi = ni; X[tt][p] = xr; X[tt][64 + p] = xi; }
        __syncthreads();
#pragma unroll 1
        for (int h = 0; h < 16; ++h) { float y = a.in[19][g * 16 + h] * Us[p][h];
#pragma unroll 4
            for (int pp = 0; pp < 64; ++pp) y += cre[h][pp] * X[p][pp] - cim[h][pp] * X[p][64 + pp];
            st_bf(G, ((size_t)b * SEQ + c0 + p) * 512 + g * 16 + h, gelu_tanh(y)); }
    }
}
#endif
__global__ void __launch_bounds__(NWAVES * 64, 2) mega_fwd(Args args) {
    extern __shared__ __attribute__((aligned(16))) unsigned char lds[];
    Frame F;
    F.lds = (LAS unsigned char*)lds;
    F.MISC = (volatile LAS unsigned*)(F.lds + MISC_OFF);
    F.tid = threadIdx.x; F.lane = F.tid & 63; F.wave = __builtin_amdgcn_readfirstlane(F.tid >> 6);
    F.G = gridDim.x; { const int bx = blockIdx.x; F.vcu = (F.G % 8 == 0) ? (bx % 8) * (F.G / 8) + bx / 8 : bx; }
    unsigned char* ws = args.ws;
    F.ctl = (gu32*)(ws + WS_CTL);
    for (int u = F.tid; u < (LDS_BYTES - LDSCTL_OFF) / 4; u += NWAVES * 64) ((LAS unsigned*)(F.lds + LDSCTL_OFF))[u] = 0u;
    __syncthreads();
    const int lo = args.ph_lo, hi = args.ph_hi;
    XcdBarrier bar; bar.bar = (unsigned*)(F.ctl + CW_BAR) + args.li * XCD_BAR_WORDS; bar.x = 0; bar.st = nullptr;
    if (hi - lo > 1) bar = xcd_barrier_post((unsigned*)(F.ctl + CW_BAR) + args.li * XCD_BAR_WORDS, F.MISC + 8);
#define IN(k) (lo <= (k) && (k) < hi)
#ifdef PROBE_TS
    unsigned long long ts_[10]; int nts_ = 0;
#define STAMP() do { ts_[nts_++] = __builtin_amdgcn_s_memrealtime(); } while (0)
#else
#define STAMP() do {} while (0)
#endif
    STAMP();
#define BOTH(k) (IN(k) && IN((k) + 1))
#ifndef REP_MASK
#define REP_MASK 0
#endif
#ifndef GRP_BARRIERS
#define GRP_BARRIERS 1
#endif
#define NREP(k) (((REP_MASK >> (k)) & 1) ? 2 : 1)
#ifdef PROBE_P0B
    const unsigned long long tp0_ = __builtin_amdgcn_s_memrealtime();
    p0_prologue(F, args);
    const unsigned long long tp1_ = __builtin_amdgcn_s_memrealtime();
    xcd_barrier(bar);
    const unsigned long long tp2_ = __builtin_amdgcn_s_memrealtime();
#else
    if (IN(0)) for (int r_ = 0; r_ < NREP(0); ++r_) { p0_prologue(F, args); if (BOTH(0)) xcd_barrier(bar); }
#endif
    STAMP();
#if FAST_P1
    const bool grp = GRP_BARRIERS && F.G == 256 && lo == 0 && hi == 7; const int gb = F.vcu >> 5;
    XcdBarrier gbar = bar;
    if (grp) { gbar = xcd_barrier_post((unsigned*)(F.ctl + CW_GBAR) + gb * XCD_BAR_WORDS, F.MISC + 10); gbar.nmemb = 32u; }
#define SEAM(k) do { if (grp) xcd_barrier(gbar); else xcd_barrier(bar); } while (0)
    if (IN(1)) for (int r_ = 0; r_ < NREP(1); ++r_) { phase_inproj(F, args); if (BOTH(1)) SEAM(0); }
    STAMP();
#endif
#if FAST_ATT
    if (IN(2)) for (int r_ = 0; r_ < NREP(2); ++r_) { phase_attn(F, args, (char*)lds); }
    STAMP();
#endif
#if FAST_SSM
#ifdef PROBE_SSM
    const unsigned long long tss0_ = __builtin_amdgcn_s_memrealtime();
    if (IN(3)) { phase_ssm(F, args); }
    const unsigned long long tss1_ = __builtin_amdgcn_s_memrealtime();
    if (BOTH(3)) xcd_barrier(bar);
    const unsigned long long tss2_ = __builtin_amdgcn_s_memrealtime();
#else
    if (IN(3)) for (int r_ = 0; r_ < NREP(3); ++r_) { phase_ssm(F, args); if (BOTH(3)) SEAM(1); }
#endif
    STAMP();
#endif
#if FAST_P4
    if (IN(4)) for (int r_ = 0; r_ < NREP(4); ++r_) { phase_glu_t1(F, args); if (BOTH(4)) SEAM(2); }
    STAMP();
#endif
#if FAST_P5
    if (IN(5)) { phase_merge(F, args); if (BOTH(5)) SEAM(3); }
    STAMP();
#endif
#if FAST_P6
    if (IN(6)) for (int r_ = 0; r_ < NREP(6); ++r_) { phase_out(F, args); }
    STAMP();
#ifdef PROBE_TS
    xcd_barrier(bar); STAMP();
#endif
#ifdef PROBE_P0B
    if (blockIdx.x == PROBE_BLK) { const unsigned long long d_ = (PROBE_P0B == 1) ? (tp1_ - tp0_) : (tp2_ - tp1_), t0_ = __builtin_amdgcn_s_memrealtime(); while (__builtin_amdgcn_s_memrealtime() - t0_ < d_) __builtin_amdgcn_s_sleep(8); }
#endif
#ifdef PROBE_SSM
    if (blockIdx.x == 0) { const unsigned long long d_ = (PROBE_SSM == 1) ? (tss1_ - tss0_) : (tss2_ - tss1_), t0_ = __builtin_amdgcn_s_memrealtime(); while (__builtin_amdgcn_s_memrealtime() - t0_ < d_) __builtin_amdgcn_s_sleep(8); }
#endif
#ifdef PROBE_EPI
    if (blockIdx.x == 0) { __syncthreads(); const unsigned long long d_ = ((unsigned long long)F.MISC[27] << 32) | F.MISC[26], t0_ = __builtin_amdgcn_s_memrealtime(); while (__builtin_amdgcn_s_memrealtime() - t0_ < d_) __builtin_amdgcn_s_sleep(8); }
#endif
#ifdef PROBE_ATT
    if (blockIdx.x == 0) { __syncthreads(); const unsigned long long d_ = ((unsigned long long)F.MISC[25] << 32) | F.MISC[24], t0_ = __builtin_amdgcn_s_memrealtime(); while (__builtin_amdgcn_s_memrealtime() - t0_ < d_) __builtin_amdgcn_s_sleep(8); }
#endif
#ifdef PROBE_P0
    if (blockIdx.x == 0) { __syncthreads(); const unsigned long long a_ = ((unsigned long long)F.MISC[17 + 2 * PROBE_P0] << 32) | F.MISC[16 + 2 * PROBE_P0], b_ = ((unsigned long long)F.MISC[19 + 2 * PROBE_P0] << 32) | F.MISC[18 + 2 * PROBE_P0];
        const unsigned long long d_ = b_ - a_, t0_ = __builtin_amdgcn_s_memrealtime(); while (__builtin_amdgcn_s_memrealtime() - t0_ < d_) __builtin_amdgcn_s_sleep(8); }
#endif
#ifdef PROBE_TS
    if (blockIdx.x == 0) { const unsigned long long d_ = ts_[PROBE_TS + 1] - ts_[PROBE_TS], t0_ = __builtin_amdgcn_s_memrealtime(); while (__builtin_amdgcn_s_memrealtime() - t0_ < d_) __builtin_amdgcn_s_sleep(8); }
#endif
#endif
#undef IN
#undef BOTH
}

extern "C" void kernel_launch(void* const* d_in, const int* in_sizes, int n_in, void* d_out, int out_size, void* d_ws, size_t ws_size, hipStream_t stream) {
    static int grid = 0;
    if (grid == 0) {
        if (n_in != 25 || in_sizes[0] != MTOK * DM || out_size != MTOK * DM || ws_size < WS_TOTAL) { fprintf(stderr, "kernel_launch: unexpected shapes/workspace (n_in %d, in0 %d, out %d, ws %zu)\n", n_in, n_in > 0 ? in_sizes[0] : -1, out_size, ws_size); grid = -1; return; }
        int dev = 0, cus = 0, per_cu = 0;
        if (hipGetDevice(&dev) != hipSuccess || hipDeviceGetAttribute(&cus, hipDeviceAttributeMultiprocessorCount, dev) != hipSuccess) { grid = -1; return; }
        if (hipFuncSetAttribute((const void*)mega_fwd, hipFuncAttributeMaxDynamicSharedMemorySize, LDS_BYTES) != hipSuccess) { fprintf(stderr, "kernel_launch: hipFuncSetAttribute failed\n"); grid = -1; return; }
        if (hipOccupancyMaxActiveBlocksPerMultiprocessor(&per_cu, (const void*)mega_fwd, NWAVES * 64, LDS_BYTES) != hipSuccess || per_cu < 1) fprintf(stderr, "kernel_launch: occupancy query reports %d\n", per_cu);
        (void)hipGetLastError();
        grid = cus;
    }
    if (grid < 0) return;
    if (hipMemsetAsync((char*)d_ws + WS_CTL, 0, CTL_ZERO_BYTES, stream) != hipSuccess) return;
    Args a{};
    for (int i = 0; i < 25; ++i) a.in[i] = (const float*)d_in[i];
    a.out = (float*)d_out; a.ws = (unsigned char*)d_ws;
#if USE_NAIVE
    NArgs na{}; for (int i = 0; i < 25; ++i) na.in[i] = (const float*)d_in[i]; na.out = (float*)d_out; na.ws = (unsigned char*)d_ws;
#define MEGA(lo_, hi_) do { a.ph_lo = (lo_); a.ph_hi = (hi_); hipLaunchKernelGGL(mega_fwd, dim3(grid), dim3(NWAVES * 64), LDS_BYTES, stream, a); } while (0)
    MEGA(0, 1);
#ifdef DBG_POISON_P1
    (void)hipMemsetAsync((char*)d_ws + WS_Q, 0xFF, 64 * MiB + 32 * MiB + 32 * MiB, stream);
    (void)hipMemsetAsync((char*)d_ws + WS_U, 0xFF, 48 * MiB + 32 * MiB + 128 * MiB, stream);
#endif
#if FAST_P1
    MEGA(1, 2);
#else
    hipLaunchKernelGGL(nk_gemm<1>, dim3(NCOL / 64, MTOK / 64), dim3(256), 0, stream, na);
#endif
#if FAST_ATT
    MEGA(2, 3);
#else
    hipLaunchKernelGGL(nk_attn, dim3(SEQ / 16, NH, BATCH), dim3(256), 0, stream, na);
#endif
#if FAST_SSM
    MEGA(3, 4);
#else
    hipLaunchKernelGGL(nk_ssm, dim3(BATCH * NG), dim3(64), 0, stream, na);
#endif
#if FAST_P4
    MEGA(4, 5);
#else
    hipLaunchKernelGGL(nk_gemm<3>, dim3(512 / 64, MTOK / 64), dim3(256), 0, stream, na);
    hipLaunchKernelGGL(nk_gemm<4>, dim3(1024 / 64, MTOK / 64), dim3(256), 0, stream, na);
#endif
#if FAST_P5
    MEGA(5, 6);
#else
    hipLaunchKernelGGL(nk_gemm<5>, dim3(1024 / 64, MTOK / 64), dim3(256), 0, stream, na);
#endif
#if FAST_P6
    MEGA(6, 7);
#else
    hipLaunchKernelGGL(nk_gemm<6>, dim3(1024 / 64, MTOK / 64), dim3(256), 0, stream, na);
#endif
#undef MEGA
#else
#define MEGA(lo_, hi_) do { a.ph_lo = (lo_); a.ph_hi = (hi_); hipLaunchKernelGGL(mega_fwd, dim3(grid), dim3(NWAVES * 64), LDS_BYTES, stream, a); ++a.li; } while (0)
#if defined(PROBE_MODE) && PROBE_MODE == 1
    MEGA(0, 3); MEGA(3, 4); MEGA(3, 4); MEGA(4, 7);
#elif defined(PROBE_MODE) && PROBE_MODE == 2
    MEGA(0, 6); MEGA(4, 6); MEGA(6, 7);
#elif defined(PROBE_MODE) && PROBE_MODE == 3
    MEGA(0, 3); MEGA(3, 4); MEGA(4, 7);
#else
    MEGA(0, 7);
#endif
#undef MEGA
#endif
    const hipError_t le = hipPeekAtLastError();
    if (le != hipSuccess) fprintf(stderr, "kernel_launch: launch failed: %s\n", hipGetErrorName(le));
}
```

```cpp
#define USE_NAIVE 0
#define FAST_P1 1
#define FAST_ATT 1
#define FAST_SSM 1
#define FAST_P4 1
#define FAST_P5 1
#define FAST_P6 1

#include <hip/hip_runtime.h>
#include <cstdio>
#include <cstdint>
#include <cmath>

constexpr int BATCH = 8, SEQ = 4096, DM = 1024, MTOK = BATCH * SEQ;
constexpr int NCOL = 5120;
constexpr int AW = 512, NH = 4, SD = 64, VD = 128, SW = 512, SGC = 16, NG = 32, SP = 64;
constexpr int TCH = 16;
constexpr int NCH = SEQ / TCH;
constexpr int ALD = 384;
constexpr float LOG2E = 1.4426950408889634f;
constexpr float LAM_INIT = 0.2f;

constexpr size_t MiB = 1u << 20;
constexpr size_t WS_CTL = 0, CTL_ZERO_BYTES = 256 * 1024;
constexpr size_t WS_TAB = 1 * MiB;
constexpr size_t WS_WIN = 2 * MiB;
constexpr size_t WS_GLUW = 12 * MiB;
constexpr size_t WS_PAS = 13 * MiB;
constexpr size_t WS_WOUT = 15 * MiB;
constexpr size_t WS_W2 = 17 * MiB;
constexpr size_t WS_KW = 21 * MiB;
constexpr size_t WS_G = 27 * MiB;
constexpr size_t WS_XN = 64 * MiB;
constexpr size_t WS_OAS = 64 * MiB;
constexpr size_t WS_Q = 128 * MiB;
constexpr size_t QKB = 4194304, QKK = 2097152;
constexpr size_t WS_MRG = 128 * MiB;
constexpr size_t WS_V = 192 * MiB;
constexpr size_t WS_GA = 224 * MiB;
constexpr size_t WS_U = 256 * MiB;
constexpr size_t WS_GS = 304 * MiB;
constexpr size_t WS_MG = 336 * MiB;
constexpr size_t WS_TOTAL = 464 * MiB;

constexpr int TB_LAM = 0;
constexpr int TB_M0 = 1;
constexpr int TB_CFAR = 4;
constexpr int TB_QG = 64;
constexpr int TB_KG = 128;
constexpr int TB_BIASL = 256;
constexpr int TB_LB16 = 2048;

typedef unsigned short bf16;
typedef unsigned v4u __attribute__((ext_vector_type(4)));
typedef unsigned v2u __attribute__((ext_vector_type(2)));

__host__ __device__ __forceinline__ unsigned f2bf(float f) { unsigned u = __builtin_bit_cast(unsigned, f); return (u + 0x7fffu + ((u >> 16) & 1u)) >> 16; }
__host__ __device__ __forceinline__ float bf2f(unsigned h) { return __builtin_bit_cast(float, (h & 0xffffu) << 16); }
__device__ __forceinline__ unsigned pk2(float lo, float hi) { return f2bf(lo) | (f2bf(hi) << 16); }

__host__ __device__ __forceinline__ size_t qk_index(int b, int h, int s, int t, int d) {
    return (size_t)b * QKB + ((((size_t)(h * 2 + s) * 64 + (t >> 6)) * 8 + (d >> 3)) * 64 + (t & 63)) * 8 + (d & 7);
}
__host__ __device__ __forceinline__ size_t v_index(int b, int h, int t, int dv) { return ((size_t)(b * 4 + h) * SEQ + t) * VD + dv; }
__host__ __device__ __forceinline__ size_t u_index(int b, int g, int t, int hc) { return ((size_t)(b * NG + g) * NCH + (t >> 4)) * ALD + (t & 15) * 16 + hc; }
__host__ __device__ __forceinline__ int rowmap_in(int n) {
    if (n >= 3072) { const int c = n - 3072, isS = c >> 10, ch = c & 1023; return 3072 + 256 * (ch >> 7) + 128 * isS + (ch & 127); }
    if (n >= 1024) return n;
    const int tile = n >> 8, ow = n & 255, wc = ow >> 6, rem = ow & 63, bj = rem >> 5, i = rem & 31;
    return tile * 256 + 128 * bj + 32 * wc + i;
}
__device__ __forceinline__ int rel_bucket(int rel) {
    const int side = rel > 0 ? 16 : 0; const int n = rel < 0 ? -rel : rel; int b;
    if (n < 8) b = n;
    else b = n >= 91 ? 15 : n >= 64 ? 14 : n >= 46 ? 13 : n >= 32 ? 12 : n >= 23 ? 11 : n >= 16 ? 10 : n >= 12 ? 9 : 8;
    return side + b;
}
__device__ __forceinline__ float sigmoidf_(float x) { return __builtin_amdgcn_rcpf(1.0f + __builtin_amdgcn_exp2f(-LOG2E * x)); }
__device__ __forceinline__ float siluf_(float x) { return x * __builtin_amdgcn_rcpf(1.0f + __builtin_amdgcn_exp2f(-LOG2E * x)); }
__device__ __forceinline__ float gelu_tanh(float x) {
    const float u = 0.7978845608028654f * (x + 0.044715f * x * x * x);
    const float e = __builtin_amdgcn_exp2f(-2.0f * LOG2E * u);
    return x * __builtin_amdgcn_rcpf(1.0f + e);
}
__device__ __forceinline__ void sincos_d(double x, double& s, double& c) {
    const double TWO_PI = 6.283185307179586476925286766559;
    const double k = rint(x / TWO_PI); x -= k * TWO_PI;
    const double x2 = x * x; double term = x; s = x;
#pragma unroll
    for (int n = 1; n <= 16; ++n) { term *= -x2 * (1.0 / (double)((2 * n) * (2 * n + 1))); s += term; }
    term = 1.0; c = 1.0;
#pragma unroll
    for (int n = 1; n <= 16; ++n) { term *= -x2 * (1.0 / (double)((2 * n - 1) * (2 * n))); c += term; }
}
__device__ __forceinline__ double exp_d(double x) {
    int k = 0; double ax = x < 0 ? -x : x; while (ax > 0.25) { ax *= 0.5; ++k; }
    const double y = x / (double)(1 << k); double term = 1.0, s = 1.0;
#pragma unroll
    for (int n = 1; n <= 14; ++n) { term *= y * (1.0 / (double)n); s += term; }
    for (int i = 0; i < k; ++i) s *= s;
    return s;
}
struct SsmConst { double lbr, lbi, qr, qi; };
__device__ __forceinline__ SsmConst ssm_const(const float* A_re, const float* A_im, const float* log_dt, int g, int p) {
    const double dt = exp_d((double)log_dt[g]); const double ar = (double)A_re[g * SP + p], ai = (double)A_im[g * SP + p];
    const double dec = exp_d(ar * dt); double sn, cs; sincos_d(ai * dt, sn, cs);
    SsmConst r; r.lbr = dec * cs; r.lbi = dec * sn;
    const double nr = r.lbr - 1.0, ni = r.lbi, den = ar * ar + ai * ai;
    r.qr = (nr * ar + ni * ai) / den; r.qi = (ni * ar - nr * ai) / den; return r;
}
#define GAS __attribute__((address_space(1)))
#define LAS __attribute__((address_space(3)))
typedef float f32x4 __attribute__((ext_vector_type(4)));
typedef short bf16x8 __attribute__((ext_vector_type(8)));
typedef GAS unsigned gu32;
typedef GAS unsigned long long gu64;
#define RLX_AGENT __ATOMIC_RELAXED, __HIP_MEMORY_SCOPE_AGENT
#define LDS_WAIT() asm volatile("s_waitcnt lgkmcnt(0)" ::: "memory")
#define VM_WAIT() asm volatile("s_waitcnt vmcnt(0)" ::: "memory")
__device__ __forceinline__ unsigned long long rt() { return __builtin_amdgcn_s_memrealtime(); }
#define XB_TMO      128
#define XB_XCNT(j)  (256  + 64 * (j))
#define XB_XSUB(j)  (1280 + 64 * (j))
#define XB_XGEN(j)  (2304 + 64 * (j))
#define XB_TOP      3328
#define XB_TOPGEN   3392
#define XCD_BAR_WORDS 3456
#define XB_SPIN_CAP (1u << 18)

__device__ __forceinline__ unsigned xb_ld(unsigned* p)              { return __hip_atomic_load(p, __ATOMIC_RELAXED, __HIP_MEMORY_SCOPE_AGENT); }
__device__ __forceinline__ unsigned xb_add(unsigned* p, unsigned v) { return __hip_atomic_fetch_add(p, v, __ATOMIC_RELAXED, __HIP_MEMORY_SCOPE_AGENT); }
__device__ __forceinline__ unsigned xb_xcc_id() { return (unsigned)__builtin_amdgcn_s_getreg((3 << 11) | 20) & 0xFu; }
#define XB_SPIN(cond, bar) do { unsigned _sp = 0; while (cond) { __builtin_amdgcn_s_sleep(1); \
    if ((++_sp & 255u) == 0u) { if (xb_ld(&(bar)[XB_TMO])) break; if (_sp > XB_SPIN_CAP) { atomicAdd(&(bar)[XB_TMO], 1u); break; } } } } while (0)

struct XcdBarrier {
    unsigned* bar; unsigned x; unsigned nmemb;
    volatile LAS unsigned* st;
};

__device__ __forceinline__ XcdBarrier xcd_barrier_post(unsigned* bar, volatile LAS unsigned* st) {
    XcdBarrier b; b.bar = bar; b.x = xb_xcc_id(); b.st = st; b.nmemb = 0u;
    if (threadIdx.x == 0) (void)xb_add(&bar[XB_XCNT(b.x)], 1u);
    return b;
}
__device__ __forceinline__ void xcd_barrier_complete(unsigned* bar, unsigned x, unsigned& nloc, unsigned& nx, unsigned nmemb) {
    const unsigned G = nmemb ? nmemb : gridDim.x * gridDim.y * gridDim.z;
    unsigned sum, cnt, mine, sp = 0u;
    for (;;) {
        sum = 0u; cnt = 0u; mine = 0u;
#pragma unroll
        for (unsigned j = 0; j < 16; ++j) { const unsigned c = xb_ld(&bar[XB_XCNT(j)]); sum += c; cnt += (c > 0u) ? 1u : 0u; mine = (j == x) ? c : mine; }
        if (sum == G) break;
        __builtin_amdgcn_s_sleep(1);
        if ((++sp & 255u) == 0u) { if (xb_ld(&bar[XB_TMO])) break; if (sp > XB_SPIN_CAP) { atomicAdd(&bar[XB_TMO], 1u); break; } }
    }
    nloc = mine > 0u ? mine : 1u; nx = cnt > 0u ? cnt : 1u;
}

__device__ __forceinline__ void xcd_barrier(const XcdBarrier& b) {
    asm volatile("s_waitcnt vmcnt(0)" ::: "memory");
    __syncthreads();
    if (threadIdx.x == 0) {
        unsigned* bar = b.bar;
        __builtin_amdgcn_s_waitcnt(0);
        unsigned nloc = b.st[0], nx = b.st[1];
        if (nloc == 0u) { xcd_barrier_complete(bar, b.x, nloc, nx, b.nmemb); b.st[0] = nloc; b.st[1] = nx; }
        const unsigned old = xb_add(&bar[XB_XSUB(b.x)], 1u);
        const unsigned gen = old / nloc;
        if (old + 1u == (gen + 1u) * nloc) {
            if (!(b.nmemb != 0u && nx == 1u)) {
            __builtin_amdgcn_fence(__ATOMIC_RELEASE, "agent");
            }
            asm volatile("s_waitcnt vmcnt(0)" ::: "memory");
            if (nx > 1u) {
            const unsigned og = xb_add(&bar[XB_TOP], 1u);
            const unsigned tg = og / nx;
            if (og + 1u == (tg + 1u) * nx) xb_add(&bar[XB_TOPGEN], 1u);
            else XB_SPIN(xb_ld(&bar[XB_TOPGEN]) == tg, bar);
            }
            __builtin_amdgcn_fence(__ATOMIC_ACQUIRE, "agent");
            xb_add(&bar[XB_XGEN(b.x)], 1u);
            asm volatile("s_waitcnt vmcnt(0)" ::: "memory");
        } else {
            XB_SPIN(xb_ld(&bar[XB_XGEN(b.x)]) == gen, bar);
            __builtin_amdgcn_fence(__ATOMIC_ACQUIRE, "agent");
            asm volatile("s_waitcnt vmcnt(0)" ::: "memory");
        }
    }
    __syncthreads();
}
#ifndef PG8_WGM
#define PG8_WGM 8
#endif
namespace pg8 {
#define PG8_LAS __attribute__((address_space(3)))
typedef unsigned short bf16_t;
typedef short bf16x8 __attribute__((ext_vector_type(8)));
typedef float f32x4 __attribute__((ext_vector_type(4)));
typedef unsigned u32x4 __attribute__((ext_vector_type(4)));
constexpr int BM = 256, BK = 64, HALF = 128, HTB = HALF * BK * 2  , STAGE_BYTES = 8 * HTB, NXCD = 8, WGM = PG8_WGM;

__host__ __device__ __forceinline__ int lds_byte(int r, int c) { const int st = (r >> 4) * 2 + (c >> 5), rr = r & 15, cc = c & 31, ob = rr * 64 + cc * 2; return st * 1024 + (ob ^ (((ob >> 9) & 1) << 5)); }
__host__ __device__ __forceinline__ void stage_rc(int b, int& R, int& C) { const int st = b / 1024, sb = b % 1024, swz = sb ^ (((sb >> 9) & 1) << 5); R = (st >> 1) * 16 + swz / 64; C = (st & 1) * 32 + (swz % 64) / 2; }
__host__ __device__ __forceinline__ int perm32(int rho) { const int n = rho >> 4, i = rho & 15; return 8 * (i >> 2) + 4 * n + (i & 3); }

struct Unit { int pm, pn; };
struct Gemm { const bf16_t* A; const bf16_t* Bt; int M, N, K, lda, ldb; };

struct StaticOrder {
    int nM, nN, nwg, G, c;
    __host__ __device__ void init(int M, int N, int G_, int c_) { nM = M / BM; nN = N / BM; nwg = nM * nN; G = G_; c = c_; }
    __host__ __device__ bool next(int i, Unit& u) const {
        const long L = (long)i * G + c; if (L >= nwg) return false;
        int wgid = (int)L; { const int q = nwg / NXCD, r = nwg % NXCD, xcd = wgid % NXCD, off = wgid / NXCD; wgid = (xcd < r ? xcd * (q + 1) : r * (q + 1) + (xcd - r) * q) + off; }
        const int nig = WGM * nN, gid = wgid / nig, fm = gid * WGM, gsz = (nM - fm) < WGM ? (nM - fm) : WGM;
        u.pm = fm + ((wgid % nig) % gsz); u.pn = (wgid % nig) / gsz; return true;
    }
    __device__ __forceinline__ void a_ready(const Unit&) const {}
    __device__ __forceinline__ void done(const Unit&) const {}
};

typedef float f32x2_cv __attribute__((ext_vector_type(2))); typedef __bf16 bf16x2_cv __attribute__((ext_vector_type(2)));
__device__ __forceinline__ unsigned cvt_pk_bf16(float lo, float hi) { f32x2_cv v = {lo, hi}; bf16x2_cv b = __builtin_convertvector(v, bf16x2_cv); return __builtin_bit_cast(unsigned, b); }
typedef float f32x2 __attribute__((ext_vector_type(2)));
template <class Epi, class Sched, bool ALIGN_EPI = false, bool SP2 = false, int KMID = 0>
__device__ __forceinline__ void gemm_phase(PG8_LAS unsigned char* lds, const Gemm g, const Sched& S, const Epi& E) {
    int tid_ = threadIdx.x; asm volatile("" : "+v"(tid_));
    const int tid = tid_, wid = __builtin_amdgcn_readfirstlane(tid >> 6), lane = tid & 63, wr = wid >> 2, wc = wid & 3, fr = lane & 15, fq = lane >> 4;
    const int K = g.K, nt = K / BK;
    unsigned voffA[2], voffB[2];
#pragma unroll
    for (int i = 0; i < 2; ++i) { int R, C; stage_rc(tid * 16 + i * 8192, R, C); const int Rb = Epi::PERM ? ((R & ~31) + perm32(R & 31)) : R;
        voffA[i] = (unsigned)(R * g.lda + C) * 2u; voffB[i] = (unsigned)(Rb * g.ldb + C) * 2u; }
    const size_t kstep = (size_t)(BK * 2);
    const size_t hstepA = (size_t)HALF * g.lda * 2, hstepB = (size_t)HALF * g.ldb * 2;
    const size_t tstepA = 2 * hstepA, tstepB = 2 * hstepB;
    const unsigned ldsw = (unsigned)wid * 1024u;
    const int aoff = lds_byte(wr * 64 + fr, fq * 8), boff = lds_byte(wc * 32 + fr, fq * 8);
#define PG8_SA(b, h) (((b) * 2 + (h)) * HTB)
#define PG8_SB(b, h) ((4 + (b) * 2 + (h)) * HTB)
#define PG8_STAGE(bufoff, gbase, voff) do { _Pragma("unroll") for (int _i = 0; _i < 2; ++_i) \
        __builtin_amdgcn_global_load_lds((const unsigned*)((const char*)(gbase) + (voff)[_i]), (PG8_LAS unsigned*)(lds + (bufoff) + ldsw + _i * 8192), 16, 0, 0); } while (0)
#define PG8_LDA(dst, b, h) do { _Pragma("unroll") for (int m = 0; m < 4; ++m) _Pragma("unroll") for (int k = 0; k < 2; ++k) dst[m][k] = *(const PG8_LAS bf16x8*)(lds + PG8_SA(b, h) + aoff + m * 2048 + k * 1024); } while (0)
#define PG8_LDB(dst, b, h) do { _Pragma("unroll") for (int n = 0; n < 2; ++n) _Pragma("unroll") for (int k = 0; k < 2; ++k) dst[n][k] = *(const PG8_LAS bf16x8*)(lds + PG8_SB(b, h) + boff + n * 2048 + k * 1024); } while (0)
#define PG8_MMA(ai, bj, At, Bt) do { __builtin_amdgcn_s_setprio(1); _Pragma("unroll") for (int m = 0; m < 4; ++m) _Pragma("unroll") for (int n = 0; n < 2; ++n) _Pragma("unroll") for (int k = 0; k < 2; ++k) \
        acc[ai][bj][m][n] = __builtin_amdgcn_mfma_f32_16x16x32_bf16(Bt[n][k], At[m][k], acc[ai][bj][m][n], 0, 0, 0); __builtin_amdgcn_s_setprio(0); } while (0)
#define PG8_WAIT_V(n) asm volatile("s_waitcnt vmcnt(" #n ")" ::: "memory")
#define PG8_WAIT_L(n) asm volatile("s_waitcnt lgkmcnt(" #n ")" ::: "memory")
#define PG8_BAR __builtin_amdgcn_s_barrier()
#define PG8_SCHED __builtin_amdgcn_sched_barrier(0)
    Unit cur, nxt; int ui = 0;
    if (!S.next(0, cur)) return;
    f32x4 acc[2][2][4][2];
#pragma unroll
    for (int a = 0; a < 2; ++a)
#pragma unroll
        for (int b = 0; b < 2; ++b)
#pragma unroll
            for (int m = 0; m < 4; ++m)
#pragma unroll
                for (int n = 0; n < 2; ++n) acc[a][b][m][n] = (f32x4){0.f, 0.f, 0.f, 0.f};
    bf16x8 At[4][2], B0[2][2], B1[2][2];
    const char* cA = (const char*)g.A + (size_t)cur.pm * tstepA; const char* cB = (const char*)g.Bt + (size_t)cur.pn * tstepB;
    S.a_ready(cur);
    if constexpr (SP2) {
        PG8_STAGE(PG8_SB(0, 0), cB, voffB); PG8_STAGE(PG8_SB(0, 1), cB + hstepB, voffB); PG8_STAGE(PG8_SA(0, 0), cA, voffA); PG8_STAGE(PG8_SA(0, 1), cA + hstepA, voffA);
        if (wr == 1) PG8_BAR;
        PG8_WAIT_V(2); PG8_BAR;
        PG8_STAGE(PG8_SB(1, 0), cB + kstep, voffB); PG8_STAGE(PG8_SA(1, 0), cA + kstep, voffA); PG8_STAGE(PG8_SB(1, 1), cB + hstepB + kstep, voffB);
        PG8_WAIT_V(6); PG8_BAR;
    } else {
        PG8_STAGE(PG8_SB(0, 0), cB, voffB); PG8_STAGE(PG8_SA(0, 0), cA, voffA); PG8_STAGE(PG8_SB(0, 1), cB + hstepB, voffB); PG8_STAGE(PG8_SA(0, 1), cA + hstepA, voffA);
        if (wr == 1) PG8_BAR;
        PG8_WAIT_V(4); PG8_BAR;
        PG8_STAGE(PG8_SB(1, 0), cB + kstep, voffB); PG8_STAGE(PG8_SA(1, 0), cA + kstep, voffA); PG8_STAGE(PG8_SB(1, 1), cB + hstepB + kstep, voffB);
        PG8_WAIT_V(6); PG8_BAR;
    }
    for (;;) {
        const bool has_next = S.next(ui + 1, nxt);
        const char* nA = has_next ? (const char*)g.A + (size_t)nxt.pm * tstepA : cA; const char* nB = has_next ? (const char*)g.Bt + (size_t)nxt.pn * tstepB : cB;
        for (int t = 0; t < nt; t += 2) {
            if constexpr (KMID != 0) { if (t == KMID / BK) E.mid(acc, cur, wr, wc, fr, fq); }
            const bool last = (t == nt - 2);
            const char* a1 = cA + (size_t)(t + 1) * kstep;
            const char* a2 = last ? nA : cA + (size_t)(t + 2) * kstep; const char* b2 = last ? nB : cB + (size_t)(t + 2) * kstep;
            const char* a3 = a2 + kstep; const char* b3 = b2 + kstep;
            if (last && has_next) S.a_ready(nxt);
            if constexpr (SP2) {
            PG8_LDB(B0, 0, 0); PG8_LDB(B1, 0, 1); PG8_SCHED; PG8_LDA(At, 0, 0); PG8_STAGE(PG8_SA(1, 1), a1 + hstepA, voffA);
            PG8_WAIT_V(8); PG8_WAIT_L(0); PG8_BAR; PG8_MMA(0, 0, At, B0); PG8_MMA(0, 1, At, B1); PG8_BAR; PG8_SCHED;
            PG8_LDA(At, 0, 1); PG8_STAGE(PG8_SB(0, 0), b2, voffB); PG8_STAGE(PG8_SB(0, 1), b2 + hstepB, voffB); PG8_STAGE(PG8_SA(0, 0), a2, voffA);
            PG8_WAIT_V(8); PG8_WAIT_L(0); PG8_BAR; PG8_MMA(1, 0, At, B0); PG8_MMA(1, 1, At, B1); PG8_BAR; PG8_SCHED;
            PG8_LDB(B0, 1, 0); PG8_LDB(B1, 1, 1); PG8_SCHED; PG8_LDA(At, 1, 0); PG8_STAGE(PG8_SA(0, 1), a2 + hstepA, voffA);
            PG8_WAIT_V(8); PG8_WAIT_L(0); PG8_BAR; PG8_MMA(0, 0, At, B0); PG8_MMA(0, 1, At, B1); PG8_BAR; PG8_SCHED;
            PG8_LDA(At, 1, 1); PG8_STAGE(PG8_SB(1, 0), b3, voffB); PG8_STAGE(PG8_SB(1, 1), b3 + hstepB, voffB); PG8_STAGE(PG8_SA(1, 0), a3, voffA);
            PG8_WAIT_V(8); PG8_WAIT_L(0); PG8_BAR; PG8_MMA(1, 0, At, B0); PG8_MMA(1, 1, At, B1); PG8_BAR; PG8_SCHED;
            } else {
            PG8_LDB(B0, 0, 0); PG8_SCHED; PG8_LDA(At, 0, 0); PG8_STAGE(PG8_SA(1, 1), a1 + hstepA, voffA);
            PG8_WAIT_L(8); PG8_BAR; PG8_WAIT_L(0); PG8_MMA(0, 0, At, B0); PG8_BAR; PG8_SCHED;
            PG8_LDB(B1, 0, 1); PG8_STAGE(PG8_SB(0, 0), b2, voffB);
            PG8_BAR; PG8_WAIT_L(0); PG8_MMA(0, 1, At, B1); PG8_BAR;
            PG8_LDA(At, 0, 1); PG8_STAGE(PG8_SA(0, 0), a2, voffA);
            PG8_BAR; PG8_WAIT_L(0); PG8_MMA(1, 0, At, B0); PG8_BAR; PG8_SCHED;
            PG8_STAGE(PG8_SB(0, 1), b2 + hstepB, voffB);
            PG8_WAIT_V(6); PG8_BAR; PG8_MMA(1, 1, At, B1); PG8_BAR;
            PG8_LDB(B0, 1, 0); PG8_SCHED; PG8_LDA(At, 1, 0); PG8_STAGE(PG8_SA(0, 1), a2 + hstepA, voffA);
            PG8_WAIT_L(8); PG8_BAR; PG8_WAIT_L(0); PG8_MMA(0, 0, At, B0); PG8_BAR; PG8_SCHED;
            PG8_LDB(B1, 1, 1); PG8_STAGE(PG8_SB(1, 0), b3, voffB);
            PG8_BAR; PG8_WAIT_L(0); PG8_MMA(0, 1, At, B1); PG8_BAR;
            PG8_LDA(At, 1, 1); PG8_STAGE(PG8_SA(1, 0), a3, voffA);
            PG8_BAR; PG8_WAIT_L(0); PG8_MMA(1, 0, At, B0); PG8_BAR; PG8_SCHED;
            PG8_STAGE(PG8_SB(1, 1), b3 + hstepB, voffB);
            PG8_WAIT_V(6); PG8_BAR; PG8_MMA(1, 1, At, B1); PG8_BAR;
            }
        }
        if constexpr (ALIGN_EPI) { if (wr == 0) PG8_BAR; }
#ifdef PROBE_EPI
        const unsigned long long te0_ = __builtin_amdgcn_s_memrealtime();
#endif
        if constexpr (!Epi::AFTER_DRAIN) { E(acc, cur, wr, wc, fr, fq); S.done(cur); }
#ifdef PROBE_EPI
        if (tid == 0) { volatile PG8_LAS unsigned* mm = (volatile PG8_LAS unsigned*)(lds + 131072 + 320); const unsigned long long d_ = __builtin_amdgcn_s_memrealtime() - te0_; const unsigned long long acc_ = (((unsigned long long)mm[27] << 32) | mm[26]) + d_; mm[26] = (unsigned)acc_; mm[27] = (unsigned)(acc_ >> 32); }
#endif
        if (!has_next) break;
#pragma unroll
        for (int a = 0; a < 2; ++a)
#pragma unroll
            for (int b = 0; b < 2; ++b)
#pragma unroll
                for (int m = 0; m < 4; ++m)
#pragma unroll
                    for (int n = 0; n < 2; ++n) acc[a][b][m][n] = (f32x4){0.f, 0.f, 0.f, 0.f};
        cur = nxt; cA = nA; cB = nB; ++ui;
        if constexpr (ALIGN_EPI) { if (wr == 1) PG8_BAR; }
    }
    PG8_WAIT_V(0);
    if constexpr (!ALIGN_EPI) { if (wr == 0) PG8_BAR; }
    PG8_BAR;
    if constexpr (Epi::AFTER_DRAIN) { E.fused(acc, cur, wr, wc, fr, fq, lds, wid, lane); S.done(cur); }
#undef PG8_SA
#undef PG8_SB
#undef PG8_STAGE
#undef PG8_LDA
#undef PG8_LDB
#undef PG8_MMA
#undef PG8_WAIT_V
#undef PG8_WAIT_L
#undef PG8_BAR
#undef PG8_SCHED
}
}
namespace pg8 {
#ifdef EPI_SC1
__device__ __forceinline__ void st16(void* p, const u32x4 v) { asm volatile("global_store_dwordx4 %0, %1, off sc1\n\ts_nop 1" :: "v"(p), "v"(v) : "memory"); }
#else
__device__ __forceinline__ void st16(void* p, const u32x4 v) { *(u32x4*)p = v; }
#endif
__device__ __forceinline__ u32x4 pack8(const f32x4 a, const f32x4 b) { u32x4 w; w.x = cvt_pk_bf16(a[0], a[1]); w.y = cvt_pk_bf16(a[2], a[3]); w.z = cvt_pk_bf16(b[0], b[1]); w.w = cvt_pk_bf16(b[2], b[3]); return w; }
__device__ __forceinline__ void unpack8(const u32x4 w, f32x4& a, f32x4& b) {
    a[0] = __builtin_bit_cast(float, w.x << 16); a[1] = __builtin_bit_cast(float, w.x & 0xffff0000u); a[2] = __builtin_bit_cast(float, w.y << 16); a[3] = __builtin_bit_cast(float, w.y & 0xffff0000u);
    b[0] = __builtin_bit_cast(float, w.z << 16); b[1] = __builtin_bit_cast(float, w.z & 0xffff0000u); b[2] = __builtin_bit_cast(float, w.w << 16); b[3] = __builtin_bit_cast(float, w.w & 0xffff0000u);
}
__device__ __forceinline__ f32x4 silu4(const f32x4 v) { f32x4 o; for (int e = 0; e < 4; ++e) o[e] = siluf_(v[e]); return o; }
__device__ __forceinline__ f32x4 sigm4(const f32x4 v) { f32x4 o; for (int e = 0; e < 4; ++e) o[e] = sigmoidf_(v[e]); return o; }
__device__ __forceinline__ f32x4 gelu4(const f32x4 v) { f32x4 o; for (int e = 0; e < 4; ++e) o[e] = gelu_tanh(v[e]); return o; }

struct EpiInProj {
    static constexpr bool PERM = true, AFTER_DRAIN = false;
    unsigned char* ws; const float* mgb; const float* subg;
    __device__ __forceinline__ void operator()(const f32x4 (&acc)[2][2][4][2], const Unit& u, int wr, int wc, int fr, int fq) const {
        asm volatile("" : "+v"(fr));
        const int pn = u.pn, row0 = u.pm * BM + wr * 64 + fr;
        if (pn < 4) {
            const float* tab = (const float*)(ws + WS_TAB) + (pn < 2 ? TB_QG : TB_KG);
            bf16_t* dst = (bf16_t*)(ws + WS_Q) + (pn < 2 ? 0 : QKK);
            const int sh = 4 * (pn & 1) + wc, h = sh >> 1, s = sh & 1;
            f32x4 g[2][2];
#pragma unroll
            for (int bj = 0; bj < 2; ++bj)
#pragma unroll
                for (int n = 0; n < 2; ++n) g[bj][n] = *(const f32x4*)(tab + 32 * bj + 8 * fq + 4 * n);
#pragma unroll
            for (int ai = 0; ai < 2; ++ai)
#pragma unroll
                for (int m = 0; m < 4; ++m) { const int row = row0 + ai * HALF + m * 16, b = row >> 12, t = row & 4095; float ss = 0.f;
#pragma unroll
                    for (int bj = 0; bj < 2; ++bj)
#pragma unroll
                        for (int n = 0; n < 2; ++n) { const f32x4 x = acc[ai][bj][m][n]; ss += (x[0] * x[0] + x[1] * x[1]) + (x[2] * x[2] + x[3] * x[3]); }
                    ss += __shfl_xor(ss, 16); ss += __shfl_xor(ss, 32);
                    const float rstd = rsqrtf(ss * (1.0f / 64.0f) + 1e-6f);
#pragma unroll
                    for (int bj = 0; bj < 2; ++bj) { const f32x4 v0 = acc[ai][bj][m][0] * rstd * g[bj][0], v1 = acc[ai][bj][m][1] * rstd * g[bj][1];
                        const size_t base = (size_t)b * QKB + ((((size_t)(h * 2 + s) * 64 + (t >> 6)) * 8 + (4 * bj + fq)) * 64 + (t & 63)) * 8;
                        st16(dst + base, pack8(v0, v1)); } }
        } else if (pn < 6) {
            bf16_t* dst = (bf16_t*)(ws + WS_V);
#pragma unroll
            for (int ai = 0; ai < 2; ++ai)
#pragma unroll
                for (int m = 0; m < 4; ++m) { const int row = row0 + ai * HALF + m * 16, b = row >> 12, t = row & 4095;
#pragma unroll
                    for (int bj = 0; bj < 2; ++bj) { const int h = 2 * (pn - 4) + bj;
                        st16(dst + ((size_t)(b * 4 + h) * SEQ + t) * VD + 32 * wc + 8 * fq, pack8(acc[ai][bj][m][0], acc[ai][bj][m][1])); } }
        } else if (pn < 8 || (pn >= 10 && pn < 12)) {
            bf16_t* dst = (bf16_t*)(ws + (pn < 8 ? WS_GA : WS_GS)); const int colt = 256 * (pn & 1) + 32 * wc + 8 * fq;
            f32x4 sg0 = (f32x4){1.f, 1.f, 1.f, 1.f}, sg1 = sg0;
            if (pn < 8) { sg0 = *(const f32x4*)(subg + 32 * wc + 8 * fq) * (1.0f - LAM_INIT); sg1 = *(const f32x4*)(subg + 32 * wc + 8 * fq + 4) * (1.0f - LAM_INIT); }
#pragma unroll
            for (int ai = 0; ai < 2; ++ai)
#pragma unroll
                for (int m = 0; m < 4; ++m) { const int row = row0 + ai * HALF + m * 16;
#pragma unroll
                    for (int bj = 0; bj < 2; ++bj) st16(dst + (size_t)row * 512 + colt + bj * HALF, pack8(silu4(acc[ai][bj][m][0]) * sg0, silu4(acc[ai][bj][m][1]) * sg1)); }
        } else if (pn < 10) {
            bf16_t* dst = (bf16_t*)(ws + WS_U);
#pragma unroll
            for (int ai = 0; ai < 2; ++ai)
#pragma unroll
                for (int m = 0; m < 4; ++m) { const int row = row0 + ai * HALF + m * 16, b = row >> 12, t = row & 4095;
#pragma unroll
                    for (int bj = 0; bj < 2; ++bj) { const int j = 256 * (pn - 8) + 128 * bj + 32 * wc + 8 * fq, g = j >> 4, hc = j & 15;
                        st16(dst + ((size_t)(b * NG + g) * NCH + (t >> 4)) * ALD + (t & 15) * 16 + hc, pack8(acc[ai][bj][m][0], acc[ai][bj][m][1])); } }
        } else {
            bf16_t* dst = (bf16_t*)(ws + WS_MG); const int ch0 = 128 * (pn - 12) + 32 * wc + 8 * fq;
            f32x4 ba[2], bs[2];
#pragma unroll
            for (int n = 0; n < 2; ++n) { ba[n] = *(const f32x4*)(mgb + ch0 + 4 * n); bs[n] = *(const f32x4*)(mgb + 1024 + ch0 + 4 * n); }
#pragma unroll
            for (int ai = 0; ai < 2; ++ai)
#pragma unroll
                for (int m = 0; m < 4; ++m) { const int row = row0 + ai * HALF + m * 16; f32x4 rr[2], gg[2];
#pragma unroll
                    for (int n = 0; n < 2; ++n) { const f32x4 a = sigm4(acc[ai][0][m][n] + ba[n]); gg[n] = sigm4(acc[ai][1][m][n] + bs[n]);
#pragma unroll
                        for (int e = 0; e < 4; ++e) rr[n][e] = a[e] * __builtin_amdgcn_rcpf(fmaxf(gg[n][e], 1e-30f)); }
                    st16(dst + (size_t)row * 2048 + ch0, pack8(rr[0], rr[1]));
                    st16(dst + (size_t)row * 2048 + 1024 + ch0, pack8(gg[0], gg[1])); }
        }
    }
};
struct EpiGlu {
    static constexpr bool PERM = true, AFTER_DRAIN = false;
    const bf16_t* G; const bf16_t* GS; bf16_t* OS; const float* glub;
    __device__ __forceinline__ void operator()(const f32x4 (&acc)[2][2][4][2], const Unit& u, int wr, int wc, int fr, int fq) const {
        asm volatile("" : "+v"(fr));
        const int row0 = u.pm * BM + wr * 64 + fr, colt = u.pn * BM + 32 * wc + 8 * fq;
        f32x4 bv[2][2];
#pragma unroll
        for (int bj = 0; bj < 2; ++bj)
#pragma unroll
            for (int n = 0; n < 2; ++n) bv[bj][n] = *(const f32x4*)(glub + colt + bj * HALF + 4 * n);
#pragma unroll
        for (int ai = 0; ai < 2; ++ai) { u32x4 gq[4][2], sq[4][2];
#pragma unroll
            for (int m = 0; m < 4; ++m)
#pragma unroll
                for (int bj = 0; bj < 2; ++bj) { const size_t ix = (size_t)(row0 + ai * HALF + m * 16) * 512 + colt + bj * HALF; gq[m][bj] = *(const u32x4*)(G + ix); sq[m][bj] = *(const u32x4*)(GS + ix); }
#pragma unroll
            for (int m = 0; m < 4; ++m) { const size_t ro = (size_t)(row0 + ai * HALF + m * 16) * 512;
#pragma unroll
                for (int bj = 0; bj < 2; ++bj) { f32x4 g0, g1, s0, s1; unpack8(gq[m][bj], g0, g1); unpack8(sq[m][bj], s0, s1);
                    st16(OS + 2 * ro + 512 + colt + bj * HALF, pack8(g0 * sigm4(acc[ai][bj][m][0] + bv[bj][0]) * s0, g1 * sigm4(acc[ai][bj][m][1] + bv[bj][1]) * s1)); } }
            asm volatile("" ::: "memory"); }
    }
};
struct EpiMerge {
    static constexpr bool PERM = true, AFTER_DRAIN = false;
    const bf16_t* MG; bf16_t* MRG;
    __device__ __forceinline__ void mid(f32x4 (&acc)[2][2][4][2], const Unit& u, int wr, int wc, int fr, int fq) const {
        asm volatile("" : "+v"(fr));
        const int row0 = u.pm * BM + wr * 64 + fr, colt = u.pn * BM + 32 * wc + 8 * fq;
#pragma unroll
        for (int ai = 0; ai < 2; ++ai)
#pragma unroll
            for (int m = 0; m < 4; ++m) { const size_t row = (size_t)(row0 + ai * HALF + m * 16);
#pragma unroll
                for (int bj = 0; bj < 2; ++bj) { const int col = colt + bj * HALF; f32x4 r0, r1; unpack8(*(const u32x4*)(MG + row * 2048 + col), r0, r1);
                    acc[ai][bj][m][0] *= r0; acc[ai][bj][m][1] *= r1; } }
    }
    __device__ __forceinline__ void operator()(const f32x4 (&acc)[2][2][4][2], const Unit& u, int wr, int wc, int fr, int fq) const {
        asm volatile("" : "+v"(fr));
        const int row0 = u.pm * BM + wr * 64 + fr, colt = u.pn * BM + 32 * wc + 8 * fq;
        u32x4 gv[2][4][2];
#pragma unroll
        for (int ai = 0; ai < 2; ++ai)
#pragma unroll
            for (int m = 0; m < 4; ++m)
#pragma unroll
                for (int bj = 0; bj < 2; ++bj) gv[ai][m][bj] = *(const u32x4*)(MG + (size_t)(row0 + ai * HALF + m * 16) * 2048 + 1024 + colt + bj * HALF);
#pragma unroll
        for (int ai = 0; ai < 2; ++ai)
#pragma unroll
            for (int m = 0; m < 4; ++m) { const size_t row = (size_t)(row0 + ai * HALF + m * 16);
#pragma unroll
                for (int bj = 0; bj < 2; ++bj) { const int col = colt + bj * HALF; f32x4 s0, s1; unpack8(gv[ai][m][bj], s0, s1);
                    st16(MRG + row * 1024 + col, pack8(s0 * acc[ai][bj][m][0], s1 * acc[ai][bj][m][1])); } }
    }
};
struct EpiOut {
    static constexpr bool PERM = true, AFTER_DRAIN = false;
    const float* x; float* out;
    __device__ __forceinline__ void operator()(const f32x4 (&acc)[2][2][4][2], const Unit& u, int wr, int wc, int fr, int fq) const {
        asm volatile("" : "+v"(fr));
        const int row0 = u.pm * BM + wr * 64 + fr, colt = u.pn * BM + 32 * wc + 8 * fq;
#pragma unroll
        for (int ai = 0; ai < 2; ++ai) { f32x4 xv[4][2][2];
#pragma unroll
            for (int m = 0; m < 4; ++m) { const size_t ro = (size_t)(row0 + ai * HALF + m * 16) * 1024;
#pragma unroll
                for (int bj = 0; bj < 2; ++bj)
#pragma unroll
                    for (int n = 0; n < 2; ++n) xv[m][bj][n] = *(const f32x4*)(x + ro + colt + bj * HALF + 4 * n); }
#pragma unroll
            for (int m = 0; m < 4; ++m) { const size_t ro = (size_t)(row0 + ai * HALF + m * 16) * 1024;
#pragma unroll
                for (int bj = 0; bj < 2; ++bj)
#pragma unroll
                    for (int n = 0; n < 2; ++n) *(f32x4*)(out + ro + colt + bj * HALF + 4 * n) = xv[m][bj][n] + acc[ai][bj][m][n]; }
            asm volatile("" ::: "memory"); }
    }
};
__device__ __forceinline__ int end_lds_idx(int k, int c) { return k * 128 + (c ^ ((k & 7) << 2)); }
struct EpiEnd {
    static constexpr bool PERM = true, AFTER_DRAIN = true;
    __device__ __forceinline__ void fused(f32x4 (&acc)[2][2][4][2], const Unit& u, int wr, int wc, int fr, int fq, PG8_LAS unsigned char* lds, int wid, int lane) const {
        PG8_LAS float* L = (PG8_LAS float*)lds;
#pragma unroll
        for (int ai = 0; ai < 2; ++ai)
#pragma unroll
            for (int m = 0; m < 4; ++m) { const int k = ai * HALF + wr * 64 + m * 16 + fr;
#pragma unroll
                for (int n = 0; n < 2; ++n) *(PG8_LAS f32x4*)(L + end_lds_idx(k, 32 * wc + 8 * fq + 4 * n)) = acc[ai][0][m][n]; }
    }
};
struct EpiY {
    static constexpr bool PERM = true, AFTER_DRAIN = false;
    bf16_t* G;
    __device__ __forceinline__ void operator()(const f32x4 (&acc)[2][2][4][2], const Unit& u, int wr, int wc, int fr, int fq) const {
        int pm_ = u.pm; asm volatile("" : "+s"(pm_), "+v"(fr));
        const int b = pm_ >> 5, g = pm_ & 31;
#pragma unroll
        for (int ai = 0; ai < 2; ++ai)
#pragma unroll
            for (int m = 0; m < 4; ++m) { const int k = ai * HALF + wr * 64 + m * 16 + fr;
#pragma unroll
                for (int bj = 0; bj < 2; ++bj) { const int ct = 128 * bj + 32 * wc + 8 * fq, tt = ct >> 4, hc = ct & 15;
                    st16(G + ((size_t)b * SEQ + 16 * k + tt) * 512 + g * 16 + hc, pack8(gelu4(acc[ai][bj][m][0]), gelu4(acc[ai][bj][m][1]))); }
                asm volatile("" ::: "memory"); }
    }
};
struct OneUnit { Unit u;
    __device__ __forceinline__ bool next(int i, Unit& o) const { if (i != 0) return false; o = u; return true; }
    __device__ __forceinline__ void a_ready(const Unit&) const {}
    __device__ __forceinline__ void done(const Unit&) const {}
};
}
constexpr int NWAVES = 8;
constexpr int RING_OFF = 0, RING_BYTES = 131072;
constexpr int LDSCTL_OFF = RING_BYTES, MISC_OFF = LDSCTL_OFF + 320;
constexpr int LDS_EXTRA_OFF = RING_BYTES + 1024;
constexpr int LDS_BYTES = 147456;
constexpr int CW_TMO = 0, CW_CODE = 1, CW_BAR = 4096, CW_ATTQ = 1024;

constexpr int CW_GBAR = 8192;

struct Args { const float* in[25]; float* out; unsigned char* ws; int ph_lo, ph_hi, li, pad; };

struct Frame {
    LAS unsigned char* lds;
    volatile LAS unsigned* MISC;
    gu32* ctl;
    int tid, lane, wave, vcu, G;
};

__device__ __forceinline__ float wave_sum(float v) {
#pragma unroll
    for (int o = 1; o < 64; o <<= 1) v += __shfl_xor(v, o);
    return v;
}
template <bool MAP> __device__ __forceinline__ void p0_transpose_item(const float* W, int K, int N, bf16* WT, int ldw, LAS float* scr, int item, int lane) {
    const int nblk = N / 32, kb = item / nblk, nb = item % nblk, k0 = 64 * kb, n0 = 32 * nb;
    f32x4 wv[8];
#pragma unroll
    for (int i = 0; i < 8; ++i) wv[i] = *(const GAS f32x4*)(W + (size_t)(k0 + 8 * i + (lane >> 3)) * N + n0 + 4 * (lane & 7));
#pragma unroll
    for (int i = 0; i < 8; ++i) { LAS float* d = scr + (8 * i + (lane >> 3)) * 33 + 4 * (lane & 7); d[0] = wv[i].x; d[1] = wv[i].y; d[2] = wv[i].z; d[3] = wv[i].w; }
    LDS_WAIT(); asm volatile("" ::: "memory");
    const int c = lane & 7;
#pragma unroll
    for (int j = 0; j < 4; ++j) { const int n = (lane >> 3) + 8 * j; const LAS float* s = scr + (8 * c) * 33 + n;
        v4u o; o.x = pk2(s[0 * 33], s[1 * 33]); o.y = pk2(s[2 * 33], s[3 * 33]); o.z = pk2(s[4 * 33], s[5 * 33]); o.w = pk2(s[6 * 33], s[7 * 33]);
        const int dr = MAP ? rowmap_in(n0 + n) : (n0 + n);
        *(GAS v4u*)(WT + (size_t)dr * ldw + k0 + 8 * c) = o; }
    LDS_WAIT(); asm volatile("" ::: "memory");
}
struct XnBatch { f32x4 v[4][4]; };
__device__ __forceinline__ void xn_load(XnBatch& B, int lane, const float* x, int m0, int mstride) {
#pragma unroll
    for (int r = 0; r < 4; ++r) { const GAS f32x4* xr = (const GAS f32x4*)(x + (size_t)(m0 + r * mstride) * DM) + lane;
#pragma unroll
        for (int j = 0; j < 4; ++j) B.v[r][j] = xr[64 * j]; }
}
__device__ __forceinline__ void xn_finish(const XnBatch& B, int lane, const float* gain, bf16* xn, int m0, int mstride) {
    const GAS f32x4* gr = (const GAS f32x4*)gain + lane;
    f32x4 gg[4];
#pragma unroll
    for (int j = 0; j < 4; ++j) gg[j] = gr[64 * j];
#pragma unroll
    for (int r = 0; r < 4; ++r) { float s = 0.f;
#pragma unroll
        for (int j = 0; j < 4; ++j) s += (B.v[r][j].x * B.v[r][j].x + B.v[r][j].y * B.v[r][j].y) + (B.v[r][j].z * B.v[r][j].z + B.v[r][j].w * B.v[r][j].w);
        const float rstd = 1.0f / sqrtf(wave_sum(s) * (1.f / DM) + 1e-6f);
        GAS unsigned long long* o8 = (GAS unsigned long long*)(xn + (size_t)(m0 + r * mstride) * DM) + lane;
#pragma unroll
        for (int j = 0; j < 4; ++j)
            o8[64 * j] = (unsigned long long)pk2(B.v[r][j].x * rstd * gg[j].x, B.v[r][j].y * rstd * gg[j].y) | ((unsigned long long)pk2(B.v[r][j].z * rstd * gg[j].z, B.v[r][j].w * rstd * gg[j].w) << 32); }
}
#define P0_SSM_LDS() LAS float* L = (LAS float*)(F.lds + RING_OFF); LAS float* pwr = L; LAS float* pwi = L + 17 * 64; LAS float* bbr = L + 34 * 64; LAS float* bbi = bbr + 1024; \
    LAS float* cre = bbi + 1024; LAS float* cim = cre + 1024; LAS float* klag = cim + 1024; const int tid = F.tid; unsigned char* ws = args.ws; (void)klag; (void)ws; (void)cim; (void)cre; (void)bbi; (void)bbr; (void)pwi; (void)pwr;
__device__ __forceinline__ void p0_ssm_step1(Frame& F, const Args& args, int g, int q) {
    P0_SSM_LDS()
    if (tid < 64) {
        const int p = tid; const SsmConst sc = ssm_const(args.in[12], args.in[13], args.in[14], g, p);
        double wr = 1.0, wi = 0.0;
        for (int j = 0; j <= 16; ++j) { pwr[j * 64 + p] = (float)wr; pwi[j * 64 + p] = (float)wi; const double nr = wr * sc.lbr - wi * sc.lbi, ni = wr * sc.lbi + wi * sc.lbr; wr = nr; wi = ni; }
        if (q == 0) { float* tab = (float*)(ws + WS_TAB); tab[TB_LB16 + (g * 64 + p) * 2 + 0] = pwr[16 * 64 + p]; tab[TB_LB16 + (g * 64 + p) * 2 + 1] = pwi[16 * 64 + p]; }
        for (int h = 0; h < 16; ++h) { const double br = args.in[15][(g * SP + p) * 16 + h], bi = args.in[16][(g * SP + p) * 16 + h];
            bbr[p * 16 + h] = (float)(sc.qr * br - sc.qi * bi); bbi[p * 16 + h] = (float)(sc.qr * bi + sc.qi * br); }
    }
    for (int i = tid; i < 1024; i += 512) { cre[i] = args.in[17][g * 1024 + i]; cim[i] = args.in[18][g * 1024 + i]; }
}
__device__ __forceinline__ void p0_ssm_klag(Frame& F, const Args& args, int g, int q) {
    P0_SSM_LDS()
    { const int j = tid >> 5, h = (tid >> 1) & 15, oc = tid & 1;
      if (j <= 2 * q + 1) { float s[8] = {0.f, 0.f, 0.f, 0.f, 0.f, 0.f, 0.f, 0.f};
        for (int p = 0; p < 64; ++p) { const float cr = cre[h * 64 + p], ci = cim[h * 64 + p], wr = pwr[j * 64 + p], wi = pwi[j * 64 + p];
            const float er = cr * wr - ci * wi, ei = cr * wi + ci * wr;
#pragma unroll
            for (int e = 0; e < 8; ++e) s[e] += er * bbr[p * 16 + 8 * oc + e] - ei * bbi[p * 16 + 8 * oc + e]; }
#pragma unroll
        for (int e = 0; e < 8; ++e) { const int h2 = 8 * oc + e; klag[(j * 16 + h) * 16 + h2] = s[e] + ((j == 0 && h == h2) ? args.in[19][g * 16 + h] : 0.f); } } }
}
__device__ __forceinline__ void p0_ssm_fill(Frame& F, const Args& args, int g, int q) {
    P0_SSM_LDS()
    bf16* W2 = (bf16*)(ws + WS_W2); bf16* KW = (bf16*)(ws + WS_KW);
    for (int task = tid; task < 32 * 32; task += 512) { const int n = 32 * q + (task >> 5), k8 = task & 31, s = k8 >> 1; float v[8];
#pragma unroll
        for (int e = 0; e < 8; ++e) { const int h2 = 8 * (k8 & 1) + e; float val = 0.f;
            if (n < 128) { const int p = n & 63; const float wr = pwr[(15 - s) * 64 + p], wi = pwi[(15 - s) * 64 + p], br = bbr[p * 16 + h2], bi = bbi[p * 16 + h2];
                val = (n >> 6) ? (wr * bi + wi * br) : (wr * br - wi * bi); }
            v[e] = val; }
        v4u o; o.x = pk2(v[0], v[1]); o.y = pk2(v[2], v[3]); o.z = pk2(v[4], v[5]); o.w = pk2(v[6], v[7]);
        *(GAS v4u*)(W2 + (size_t)(g * 256 + n) * 256 + 8 * k8) = o; }
    for (int task = tid; task < 32 * 48; task += 512) { const int n = 32 * q + task / 48, k8 = task % 48, t = n >> 4, h = n & 15; float v[8];
#pragma unroll
        for (int e = 0; e < 8; ++e) { float val;
            if (k8 < 32) { const int s = k8 >> 1, h2 = 8 * (k8 & 1) + e; val = (s <= t) ? klag[((t - s) * 16 + h) * 16 + h2] : 0.f; }
            else { const int kk = 8 * (k8 - 32) + e, part = kk >> 6, p = kk & 63; const float wr = pwr[(t + 1) * 64 + p], wi = pwi[(t + 1) * 64 + p], cr = cre[h * 64 + p], ci = cim[h * 64 + p];
                val = part ? -(cr * wi + ci * wr) : (cr * wr - ci * wi); }
            v[e] = val; }
        v4u o; o.x = pk2(v[0], v[1]); o.y = pk2(v[2], v[3]); o.z = pk2(v[4], v[5]); o.w = pk2(v[6], v[7]);
        *(GAS v4u*)(KW + (size_t)(g * 256 + n) * ALD + 8 * k8) = o; }
}
__device__ __forceinline__ void p0_attn_tables(Frame& F, const Args& args) {
    LAS float* L = (LAS float*)(F.lds + RING_OFF); float* tab = (float*)(args.ws + WS_TAB); const int tid = F.tid;
    if (tid < 64) {
        float s1 = args.in[6][tid] * args.in[7][tid], s2 = args.in[8][tid] * args.in[9][tid];
        float mq = fabsf(args.in[4][tid]), mk = fabsf(args.in[5][tid]), mt = fmaxf(fabsf(args.in[11][tid]), fabsf(args.in[11][64 + tid]));
#pragma unroll
        for (int o = 1; o < 64; o <<= 1) { s1 += __shfl_xor(s1, o); s2 += __shfl_xor(s2, o); mq = fmaxf(mq, __shfl_xor(mq, o)); mk = fmaxf(mk, __shfl_xor(mk, o)); mt = fmaxf(mt, __shfl_xor(mt, o)); }
        const float m0 = 8.0f * mq * mk + mt;
        if (tid == 0) { tab[TB_LAM] = expf(s1) - expf(s2) + LAM_INIT; tab[TB_M0] = m0; L[0] = m0; }
    }
    __syncthreads();
    const float m0 = L[0];
    if (tid < 4) tab[TB_CFAR + tid] = (args.in[11][15 * 4 + tid] - m0) * LOG2E;
    if (tid < 64) { tab[TB_QG + tid] = args.in[4][tid] * 0.125f * LOG2E; tab[TB_KG + tid] = args.in[5][tid]; }
    for (int i = tid; i < 1024; i += 512) { const int h = i >> 8, idx = i & 255; tab[TB_BIASL + i] = (args.in[11][rel_bucket(idx - 192) * 4 + h] - m0) * LOG2E; }
    __syncthreads();
}
__device__ __forceinline__ void p0_prologue(Frame& F, const Args& args) {
    unsigned char* ws = args.ws;
    const int gw = F.vcu * NWAVES + F.wave, NGW = F.G * NWAVES;
    const int g = F.vcu >> 3, q = F.vcu & 7; const bool ssm = F.vcu < 8 * NG;
    bf16* XN = (bf16*)(ws + WS_XN); const float* x = args.in[0]; const float* gain = args.in[1];
    XnBatch B0, B1;
    int m = gw;
#define XN_HAVE(mm) ((mm) + 3 * NGW < MTOK)
    const bool h0 = XN_HAVE(m), h1 = XN_HAVE(m + 4 * NGW), h2 = XN_HAVE(m + 8 * NGW), h3 = XN_HAVE(m + 12 * NGW);
    if (h0) xn_load(B0, F.lane, x, m, NGW);
    if (h1) xn_load(B1, F.lane, x, m + 4 * NGW, NGW);
    if (ssm) p0_ssm_step1(F, args, g, q);
    __syncthreads();
    if (h0) xn_finish(B0, F.lane, gain, XN, m, NGW);
    if (h2) xn_load(B0, F.lane, x, m + 8 * NGW, NGW);
    if (ssm) p0_ssm_klag(F, args, g, q);
    __syncthreads();
    if (h1) xn_finish(B1, F.lane, gain, XN, m + 4 * NGW, NGW);
    if (h3) xn_load(B1, F.lane, x, m + 12 * NGW, NGW);
    if (ssm) p0_ssm_fill(F, args, g, q);
    __syncthreads();
    if (F.vcu == F.G - 1) p0_attn_tables(F, args);
    if (h2) xn_finish(B0, F.lane, gain, XN, m + 8 * NGW, NGW);
    LAS float* scr = (LAS float*)(F.lds + RING_OFF + F.wave * 16384);
    constexpr int I_IN = (DM / 64) * (NCOL / 32), I_GLU = (SW / 64) * (SW / 32), I_PA = (AW / 64) * (DM / 32), I_PS = (SW / 64) * (DM / 32), I_WO = (DM / 64) * (DM / 32);
    constexpr int NITEMS = I_IN + I_GLU + I_PA + I_PS + I_WO;
    for (int it = gw; it < NITEMS; it += NGW) {
        int r = it;
        if (r < I_IN) { p0_transpose_item<true>(args.in[2], DM, NCOL, (bf16*)(ws + WS_WIN), DM, scr, r, F.lane); }
        else if ((r -= I_IN) < I_GLU) { p0_transpose_item<false>(args.in[20], SW, SW, (bf16*)(ws + WS_GLUW), SW, scr, r, F.lane); }
        else if ((r -= I_GLU) < I_PA) { p0_transpose_item<false>(args.in[22], AW, DM, (bf16*)(ws + WS_PAS), 1024, scr, r, F.lane); }
        else if ((r -= I_PA) < I_PS) { p0_transpose_item<false>(args.in[23], SW, DM, (bf16*)(ws + WS_PAS) + 512, 1024, scr, r, F.lane); }
        else { r -= I_PS; p0_transpose_item<false>(args.in[24], DM, DM, (bf16*)(ws + WS_WOUT), DM, scr, r, F.lane); }
    }
    if (h3) xn_finish(B1, F.lane, gain, XN, m + 12 * NGW, NGW);
    m += 4 * NGW * ((h0 ? 1 : 0) + (h1 ? 1 : 0) + (h2 ? 1 : 0) + (h3 ? 1 : 0));
    while (XN_HAVE(m)) { xn_load(B0, F.lane, x, m, NGW); xn_finish(B0, F.lane, gain, XN, m, NGW); m += 4 * NGW; }
    for (; m < MTOK; m += NGW) { const GAS f32x4* xr = (const GAS f32x4*)(x + (size_t)m * DM) + F.lane; f32x4 v[4]; float s2 = 0.f;
#pragma unroll
        for (int j = 0; j < 4; ++j) { v[j] = xr[64 * j]; s2 += (v[j].x * v[j].x + v[j].y * v[j].y) + (v[j].z * v[j].z + v[j].w * v[j].w); }
        const float rstd = 1.0f / sqrtf(wave_sum(s2) * (1.f / DM) + 1e-6f); const GAS f32x4* gr = (const GAS f32x4*)gain + F.lane; GAS unsigned long long* o8 = (GAS unsigned long long*)(XN + (size_t)m * DM) + F.lane;
#pragma unroll
        for (int j = 0; j < 4; ++j) { const f32x4 gg = gr[64 * j]; o8[64 * j] = (unsigned long long)pk2(v[j].x * rstd * gg.x, v[j].y * rstd * gg.y) | ((unsigned long long)pk2(v[j].z * rstd * gg.z, v[j].w * rstd * gg.w) << 32); } }
#undef XN_HAVE
}
namespace att {
typedef float f32x16 __attribute__((ext_vector_type(16)));
typedef short s16x4 __attribute__((ext_vector_type(4)));
typedef short v4i16_t __attribute__((ext_vector_type(4)));
typedef short bf16x8 __attribute__((ext_vector_type(8)));
typedef unsigned u32x4 __attribute__((ext_vector_type(4)));
typedef float f32x2_t __attribute__((ext_vector_type(2))); typedef __bf16 bf16x2_t __attribute__((ext_vector_type(2)));
typedef __attribute__((address_space(3))) const char* lds_cptr;
typedef __attribute__((address_space(3))) char* lds_ptr;
constexpr int SLOT = 16384, NSLOT = 3;
constexpr int L_K = 0, L_V = NSLOT * SLOT, L_X3 = 2 * NSLOT * SLOT;
__device__ __forceinline__ int x_off(int qg) { return qg == 0 ? 2 * SLOT : qg == 1 ? L_V + SLOT : qg == 2 ? L_V + 2 * SLOT : L_X3; }
constexpr int L_LS = LDS_EXTRA_OFF, L_BIAS = LDS_EXTRA_OFF + 1024;
__device__ __forceinline__ int crow(int r, int hi) { return (r & 3) + 8 * (r >> 2) + 4 * hi; }
__device__ __forceinline__ unsigned cvtpk(float lo, float hi) { f32x2_t v = {lo, hi}; bf16x2_t b = __builtin_convertvector(v, bf16x2_t); return __builtin_bit_cast(unsigned, b); }
__device__ __forceinline__ s16x4 vtr(lds_cptr p) { return __builtin_bit_cast(s16x4, __builtin_amdgcn_ds_read_tr16_b64_v4i16((__attribute__((address_space(3))) v4i16_t*)p)); }
__device__ __forceinline__ void glds16(const void* gsrc, unsigned lds_dst) { unsigned keep;
    asm volatile("s_mov_b32 %0, m0\n\ts_mov_b32 m0, %2\n\ts_nop 0\n\tglobal_load_lds_dwordx4 %1, off\n\ts_mov_b32 m0, %0" : "=&s"(keep) : "v"(gsrc), "s"(lds_dst) : "memory"); }
#define ATT_WAITV(N) asm volatile("s_waitcnt vmcnt(" #N ")" ::: "memory")
#define ATT_BAR() do { asm volatile("s_waitcnt lgkmcnt(0)" ::: "memory"); __builtin_amdgcn_s_barrier(); asm volatile("" ::: "memory"); } while (0)

struct UnitId { int b, h, qb; };
struct UnitSrc { const bf16* ksrc[2]; const bf16* vsrc[2]; const bf16* qp; };
__device__ __forceinline__ UnitSrc unit_src(const UnitId u, unsigned char* ws, int wid, int lane) {
    const bf16* Qg = (const bf16*)(ws + WS_Q) + (size_t)u.b * QKB; const bf16* Kg = Qg + QKK; const bf16* Vg = (const bf16*)(ws + WS_V);
    const int qg = wid & 3, s = wid >> 2, r32 = lane & 31; UnitSrc S;
#pragma unroll
    for (int i = 0; i < 2; ++i) { const int pi = 2 * wid + i, ss = pi >> 3, c = pi & 7, db = pi >> 2, ks = pi & 3;
        S.ksrc[i] = Kg + (size_t)(u.h * 2 + ss) * 64 * 4096 + c * 512 + lane * 8;
        S.vsrc[i] = Vg + ((size_t)(u.b * 4 + u.h) * SEQ + 16 * ks + (lane >> 2)) * VD + 32 * db + (lane & 3) * 8; }
    S.qp = Qg + ((size_t)(u.h * 2 + s) * 64 + (2 * u.qb + (qg >> 1))) * 4096 + (32 * (qg & 1) + r32) * 8;
    return S;
}
__device__ __forceinline__ int attn_unit(const UnitId cu, bool first, bool has_next_s, const UnitId nx_s, unsigned* qcnt, unsigned char* ws, LAS unsigned char* lds, bf16x8 (&qf)[4]) {
    const int b = cu.b, h = cu.h, qb = cu.qb;
    int tid_ = threadIdx.x; asm volatile("" : "+v"(tid_));
    const int tid = tid_, lane = tid & 63, r32 = lane & 31, hi = lane >> 5;
    const int wid = __builtin_amdgcn_readfirstlane(tid >> 6), qg = wid & 3, s = wid >> 2;
    const float* tab = (const float*)(ws + WS_TAB);
#ifdef PROBE_ATT
    const unsigned long long tent_ = __builtin_amdgcn_s_memrealtime();
#endif
    const int NT = 2 * qb + 2;
    const int NTw = 2 * qb + (qg >> 1) + 1;
    const int tq0 = 128 * qb + 32 * qg;
    const UnitSrc US = unit_src(cu, ws, wid, lane);
    int kdst[2], vdst[2];
#pragma unroll
    for (int i = 0; i < 2; ++i) { const int pi = 2 * wid + i; kdst[i] = L_K + (pi >> 3) * 8192 + (pi & 7) * 1024; vdst[i] = L_V + ((pi >> 2) * 4 + (pi & 3)) * 1024; }
    const unsigned lds0 = (unsigned)(size_t)lds;
#define ATT_DMAK_(src, t, slot) do { _Pragma("unroll") for (int i_ = 0; i_ < 2; ++i_) \
        glds16((src).ksrc[i_] + (size_t)(t) * 4096, (unsigned)__builtin_amdgcn_readfirstlane((int)(lds0 + kdst[i_] + (slot) * SLOT))); } while (0)
#define ATT_DMAV_(src, t, slot) do { _Pragma("unroll") for (int i_ = 0; i_ < 2; ++i_) \
        glds16((src).vsrc[i_] + (size_t)(t) * 64 * VD, (unsigned)__builtin_amdgcn_readfirstlane((int)(lds0 + vdst[i_] + (slot) * SLOT))); } while (0)
#define ATT_DMAK(t, slot) ATT_DMAK_(US, t, slot)
#define ATT_DMAV(t, slot) ATT_DMAV_(US, t, slot)
#define ATT_QLOAD(src) do { _Pragma("unroll") for (int d0 = 0; d0 < 4; ++d0) qf[d0] = *(const bf16x8*)((src).qp + (2 * d0 + hi) * 512); } while (0)
    if (first) {
        ATT_DMAK(0, 0); ATT_DMAK(1, 1); ATT_DMAV(0, 0);
        ATT_QLOAD(US);
        if (tid < 256) ((LAS float*)(lds + L_BIAS))[tid] = tab[TB_BIASL + h * 256 + tid] - tab[TB_CFAR + h];
    }
    const float cfar = tab[TB_CFAR + h], lam = tab[TB_LAM];
    asm volatile("" :: "v"(cfar), "v"(lam), "v"(qf[0]), "v"(qf[1]), "v"(qf[2]), "v"(qf[3]));
    f32x16 o[4];
#pragma unroll
    for (int d = 0; d < 4; ++d) o[d] = (f32x16){0.f, 0.f, 0.f, 0.f, 0.f, 0.f, 0.f, 0.f, 0.f, 0.f, 0.f, 0.f, 0.f, 0.f, 0.f, 0.f};
    f32x16 lacc = (f32x16){0.f, 0.f, 0.f, 0.f, 0.f, 0.f, 0.f, 0.f, 0.f, 0.f, 0.f, 0.f, 0.f, 0.f, 0.f, 0.f};
    const bf16x8 ones = (bf16x8){0x3F80, 0x3F80, 0x3F80, 0x3F80, 0x3F80, 0x3F80, 0x3F80, 0x3F80};
    const lds_cptr kbase = (lds_cptr)lds + L_K + s * 8192 + hi * 1024 + r32 * 16;
    const lds_cptr vbase = (lds_cptr)lds + L_V + ((lane >> 4) & 1) * 32 + (lane & 3) * 8 + (4 * hi + ((lane & 15) >> 2)) * 64;
    f32x16 cfv;
#pragma unroll
    for (int r = 0; r < 16; ++r) cfv[r] = cfar;
    asm volatile("" : "+v"(cfv));
    u32x4 pw[4];
    f32x16 p0, p1;
    int slot = 0, pslot = 0;
#define ATT_SB() __builtin_amdgcn_sched_barrier(0)
#define ATT_VF(i) ({ const s16x4 lo_ = vtr(vp + (i) * 1024), hh_ = vtr(vp + (i) * 1024 + 512); (bf16x8){lo_[0], lo_[1], lo_[2], lo_[3], hh_[0], hh_[1], hh_[2], hh_[3]}; })
#define ATT_KLOAD() do { const lds_cptr kp = kbase + slot * SLOT; \
        _Pragma("unroll") for (int d0 = 0; d0 < 4; ++d0) { kf[2 * d0] = *(const __attribute__((address_space(3))) bf16x8*)(kp + d0 * 2048); \
                                                         kf[2 * d0 + 1] = *(const __attribute__((address_space(3))) bf16x8*)(kp + d0 * 2048 + 512); } } while (0)
#define ATT_QK(cv_) do { \
        p0 = __builtin_amdgcn_mfma_f32_32x32x16_bf16(kf[0], qf[0], (cv_), 0, 0, 0); \
        p1 = __builtin_amdgcn_mfma_f32_32x32x16_bf16(kf[1], qf[0], (cv_), 0, 0, 0); \
        _Pragma("unroll") for (int d0 = 1; d0 < 4; ++d0) { \
            p0 = __builtin_amdgcn_mfma_f32_32x32x16_bf16(kf[2 * d0], qf[d0], p0, 0, 0, 0); \
            p1 = __builtin_amdgcn_mfma_f32_32x32x16_bf16(kf[2 * d0 + 1], qf[d0], p1, 0, 0, 0); } } while (0)
#define ATT_NEARBIAS(t_) do { const LAS float* bt = (const LAS float*)(lds + L_BIAS) + (64 * (t_) - tq0 - r32 + 192); \
        _Pragma("unroll") for (int r = 0; r < 16; ++r) { p0[r] += bt[crow(r, hi)]; p1[r] += bt[crow(r, hi) + 32]; } } while (0)
#define ATT_PACK() do { _Pragma("unroll") for (int j = 0; j < 4; ++j) { pw[0][j] = cvtpk(p0[2 * j], p0[2 * j + 1]); pw[1][j] = cvtpk(p0[8 + 2 * j], p0[8 + 2 * j + 1]); \
                                          pw[2][j] = cvtpk(p1[2 * j], p1[2 * j + 1]); pw[3][j] = cvtpk(p1[8 + 2 * j], p1[8 + 2 * j + 1]); } } while (0)
#ifdef PROBE_ATT
    unsigned long long tseg_[7]; tseg_[1] = __builtin_amdgcn_s_memrealtime();
#define ATT_TS(i) do { tseg_[i] = __builtin_amdgcn_s_memrealtime(); } while (0)
#else
#define ATT_TS(i) do {} while (0)
#endif
    volatile LAS unsigned* qw = (volatile LAS unsigned*)(lds + MISC_OFF) + 13;
    for (int t = 0; t <= NT; ++t) {
        if (qcnt && t == NT - 1 && tid == 0) *qw = __hip_atomic_fetch_add(qcnt, 1u, __ATOMIC_RELAXED, __HIP_MEMORY_SCOPE_AGENT);
        if (t == 0 || t + 1 < NT) ATT_WAITV(4); else if (t < NT) ATT_WAITV(2); else ATT_WAITV(0);
        ATT_BAR();
        if (t + 2 < NT) { const int s2 = (slot + 2 >= NSLOT) ? slot + 2 - NSLOT : slot + 2; ATT_DMAK(t + 2, s2); }
        if (t + 1 < NT) { const int s1 = (slot + 1 >= NSLOT) ? slot + 1 - NSLOT : slot + 1; ATT_DMAV(t + 1, s1); }
        const lds_cptr vp = vbase + pslot * SLOT;
        if (t >= 1 && t < NTw) {
            const bool nearT = (t + 3 >= NTw);
            bf16x8 kf[8], vfr[4];
            ATT_KLOAD();
            vfr[0] = ATT_VF(0); vfr[1] = ATT_VF(1); vfr[2] = ATT_VF(2);
            ATT_SB();
            ATT_QK(cfv);
            if (nearT) ATT_NEARBIAS(t);
            ATT_SB();
#pragma unroll
            for (int i = 0; i < 16; ++i) {
                o[i >> 2] = __builtin_amdgcn_mfma_f32_32x32x16_bf16(__builtin_bit_cast(bf16x8, pw[i & 3]), vfr[i & 3], o[i >> 2], 0, 0, 0);
                if (i < 4) lacc = __builtin_amdgcn_mfma_f32_32x32x16_bf16(__builtin_bit_cast(bf16x8, pw[i]), ones, lacc, 0, 0, 0);
                if (i + 3 < 16) vfr[(i + 3) & 3] = ATT_VF(i + 3);
                p0[i] = __builtin_amdgcn_exp2f(p0[i]); p1[i] = __builtin_amdgcn_exp2f(p1[i]);
                ATT_SB();
            }
            ATT_PACK();
        } else if (t == 0) {
            const bool nearT = (t + 3 >= NTw);
            bf16x8 kf[8]; ATT_KLOAD();
            ATT_QK(cfv);
            if (nearT) ATT_NEARBIAS(t);
#pragma unroll
            for (int r = 0; r < 16; ++r) { p0[r] = __builtin_amdgcn_exp2f(p0[r]); p1[r] = __builtin_amdgcn_exp2f(p1[r]); }
            ATT_PACK();
        } else if (t == NTw) {
#pragma unroll
            for (int i = 0; i < 16; ++i) { const bf16x8 vf = ATT_VF(i);
                o[i >> 2] = __builtin_amdgcn_mfma_f32_32x32x16_bf16(__builtin_bit_cast(bf16x8, pw[i & 3]), vf, o[i >> 2], 0, 0, 0);
                if (i < 4) lacc = __builtin_amdgcn_mfma_f32_32x32x16_bf16(__builtin_bit_cast(bf16x8, pw[i]), ones, lacc, 0, 0, 0); }
        }
        pslot = slot; slot = (slot + 1 == NSLOT) ? 0 : slot + 1;
    }
#undef ATT_SB
#undef ATT_VF
#undef ATT_QK
#undef ATT_KLOAD
#undef ATT_NEARBIAS
#undef ATT_PACK
    ATT_TS(2);
    ATT_BAR();
    ATT_TS(3);
    int nq = 64; bool has_next = has_next_s; UnitId nx = nx_s;
    if (qcnt) { nq = (int)*qw; has_next = nq < 32; nx.b = b; nx.h = h; nx.qb = has_next ? 31 - nq : qb; }
    const int row = lane >> 2, quar = lane & 3;
    const int rbase = (s == 0) ? 16 : 0;
    const size_t tok = (size_t)b * SEQ + tq0 + rbase + row;
    u32x4 gav[4];
    { const bf16* ga = (const bf16*)(ws + WS_GA) + tok * 512 + h * 128 + quar * 32;
#pragma unroll
      for (int j = 0; j < 4; ++j) gav[j] = *(const u32x4*)(ga + j * 8); }
    if (has_next) {
        const UnitSrc NS = unit_src(nx, ws, wid, lane);
        ATT_DMAK_(NS, 0, 0); ATT_DMAK_(NS, 1, 1); ATT_DMAV_(NS, 0, 0);
        if (nx.h != h && tid < 256) ((LAS float*)(lds + L_BIAS))[tid] = tab[TB_BIASL + nx.h * 256 + tid] - tab[TB_CFAR + nx.h];
    }
    const float sc = (s == 1) ? lam : 1.0f;
#pragma unroll
    for (int r = 0; r < 16; ++r) { const float f = sc * __builtin_amdgcn_rcpf(lacc[r]);
#pragma unroll
        for (int db = 0; db < 4; ++db) o[db][r] *= f; }
    LAS float* XW = (LAS float*)(lds + x_off(qg)) + (s == 0 ? 0 : 2048);
    LAS float* XR = (LAS float*)(lds + x_off(qg)) + (s == 0 ? 2048 : 0);
    if (s == 0) {
#pragma unroll
        for (int db = 0; db < 4; ++db)
#pragma unroll
            for (int r = 0; r < 8; ++r) XW[(db * 8 + r) * 64 + lane] = o[db][r];
    } else {
#pragma unroll
        for (int db = 0; db < 4; ++db)
#pragma unroll
            for (int r = 0; r < 8; ++r) XW[(db * 8 + r) * 64 + lane] = o[db][8 + r];
    }
    ATT_BAR();
    ATT_TS(4);
    float v[4][8];
    if (s == 0) {
#pragma unroll
        for (int db = 0; db < 4; ++db)
#pragma unroll
            for (int r = 0; r < 8; ++r) v[db][r] = o[db][8 + r] - XR[(db * 8 + r) * 64 + lane];
    } else {
#pragma unroll
        for (int db = 0; db < 4; ++db)
#pragma unroll
            for (int r = 0; r < 8; ++r) v[db][r] = XR[(db * 8 + r) * 64 + lane] - o[db][r];
    }
    asm volatile("s_waitcnt lgkmcnt(0)" ::: "memory");
    LAS bf16* stg = (LAS bf16*)XR;
#pragma unroll
    for (int db = 0; db < 4; ++db)
#pragma unroll
        for (int r = 0; r < 8; ++r) { const float x_ = v[db][r]; stg[crow(r, hi) * 128 + 32 * db + r32] = (bf16)(cvtpk(x_, x_) & 0xffffu); }
    asm volatile("s_waitcnt lgkmcnt(0)" ::: "memory");
    { u32x4 w[4]; float ss = 0.f;
#pragma unroll
      for (int j = 0; j < 4; ++j) { w[j] = *(const LAS u32x4*)(stg + row * 128 + quar * 32 + j * 8);
          pg8::f32x4 a, c; pg8::unpack8(w[j], a, c); ss += (a[0] * a[0] + a[1] * a[1]) + (a[2] * a[2] + a[3] * a[3]) + (c[0] * c[0] + c[1] * c[1]) + (c[2] * c[2] + c[3] * c[3]); }
      ss += __shfl_xor(ss, 1); ss += __shfl_xor(ss, 2);
      const float rstd = rsqrtf(ss * (1.0f / 128.0f) + 1e-6f);
      bf16* oa = (bf16*)(ws + WS_OAS) + tok * 1024 + h * 128 + quar * 32;
#pragma unroll
      for (int j = 0; j < 4; ++j) { pg8::f32x4 a, c, g0, g1; pg8::unpack8(w[j], a, c); pg8::unpack8(gav[j], g0, g1);
          *(u32x4*)(oa + j * 8) = pg8::pack8(a * rstd * g0, c * rstd * g1); } }
    ATT_TS(5);
    if (has_next) { const UnitSrc NS = unit_src(nx, ws, wid, lane); ATT_QLOAD(NS); }
    ATT_BAR();
    ATT_TS(6);
#ifdef PROBE_ATT
    tseg_[0] = tent_;
    if (tid == 0) { volatile LAS unsigned* mm = (volatile LAS unsigned*)(lds + MISC_OFF); const unsigned long long d_ = tseg_[PROBE_ATT + 1] - tseg_[PROBE_ATT]; const unsigned long long acc_ = (((unsigned long long)mm[25] << 32) | mm[24]) + d_; mm[24] = (unsigned)acc_; mm[25] = (unsigned)(acc_ >> 32); }
#endif
    return nq;
#undef ATT_DMAK_
#undef ATT_DMAV_
#undef ATT_QLOAD
#undef ATT_DMAK
#undef ATT_DMAV
}
__device__ __forceinline__ void phase_attn_body(int vcu, int G, unsigned char* ws, LAS unsigned char* lds, int i0 = 0, int i1 = 4) {
    bf16x8 qf[4];
#if 1
    if (__builtin_amdgcn_readfirstlane(threadIdx.x) >= 256) __builtin_amdgcn_s_setprio(1);
#endif
    if (G == 256) {
        const int bh = vcu >> 3, s8 = vcu & 7;
#ifdef ATT_REV
#define ATT_QB_(i) ((i) == 0 ? 31 - s8 : (i) == 1 ? 16 + s8 : (i) == 2 ? 15 - s8 : s8)
#define ATT_QB(i) ATT_QB_(((vcu >> 5) & 1) ? 3 - (i) : (i))
#else
#define ATT_QB(i) ((i) == 0 ? 31 - s8 : (i) == 1 ? 16 + s8 : (i) == 2 ? 15 - s8 : s8)
#endif
#pragma unroll 1
        for (int i = i0; i < i1; ++i) { const UnitId c{bh >> 2, bh & 3, ATT_QB(i)}; const UnitId n{bh >> 2, bh & 3, ATT_QB(i + 1 < i1 ? i + 1 : i)}; (void)attn_unit(c, i == i0, i + 1 < i1, n, nullptr, ws, lds, qf); }
#undef ATT_QB
    } else {
        bool first = true;
#pragma unroll 1
        for (int uu = vcu; uu < BATCH * NH * 32; uu += G) { const UnitId c{uu >> 7, (uu >> 5) & 3, 31 - (uu & 31)}; const int nn = uu + G; const bool hn = nn < BATCH * NH * 32;
            const UnitId n{hn ? nn >> 7 : c.b, hn ? (nn >> 5) & 3 : c.h, hn ? 31 - (nn & 31) : c.qb}; (void)attn_unit(c, first, hn, n, nullptr, ws, lds, qf); first = false; }
    }
#if 1
    __builtin_amdgcn_s_setprio(0);
#endif
}
#undef ATT_WAITV
#undef ATT_BAR
}
#ifndef PG8_SP2
#define PG8_SP2 true
#endif
#ifndef PG8_ALIGN
#define PG8_ALIGN true
#endif
#ifndef ALIGN_P1
#define ALIGN_P1 true
#endif
#ifndef ALIGN_P5
#define ALIGN_P5 true
#endif
#ifndef ALIGN_P6
#define ALIGN_P6 true
#endif
__device__ __forceinline__ void phase_attn(Frame& F, const Args& args, char*, int i0 = 0, int i1 = 4) { att::phase_attn_body(F.vcu, F.G, args.ws, F.lds, i0, i1); }
__device__ __forceinline__ void phase_inproj(Frame& F, const Args& args) {
    unsigned char* ws = args.ws;
    pg8::Gemm g{(const bf16*)(ws + WS_XN), (const bf16*)(ws + WS_WIN), MTOK, NCOL, DM, DM, DM};
    pg8::StaticOrder S; S.init(MTOK, NCOL, F.G, (int)blockIdx.x);
    pg8::EpiInProj E{ws, args.in[3], args.in[10]};
    pg8::gemm_phase<pg8::EpiInProj, pg8::StaticOrder, ALIGN_P1, PG8_SP2>(F.lds + RING_OFF, g, S, E);
}
__device__ __forceinline__ void phase_ssm(Frame& F, const Args& args) {
    unsigned char* ws = args.ws;
    { const int L = F.vcu; if (L < BATCH * NG) {
        const int gg = L & 31, b = L >> 5, bg = b * NG + gg;
        pg8::OneUnit S{{bg, gg}};
        { pg8::Gemm g{(const bf16*)(ws + WS_U), (const bf16*)(ws + WS_W2), BATCH * NG * NCH, NG * 256, 256, ALD, 256};
          pg8::EpiEnd E{};
          pg8::gemm_phase<pg8::EpiEnd, pg8::OneUnit, false, PG8_SP2>(F.lds + RING_OFF, g, S, E); }
        LDS_WAIT(); __syncthreads();
        {
            const int p = F.lane, w = F.wave; const float* tab = (const float*)(ws + WS_TAB);
            const float ar = tab[TB_LB16 + (gg * 64 + p) * 2], ai = tab[TB_LB16 + (gg * 64 + p) * 2 + 1];
            const LAS float* END = (const LAS float*)(F.lds + RING_OFF);
            LAS float* EX = (LAS float*)(F.lds + LDS_EXTRA_OFF);
            float pr[32], pi[32]; float cr = 0.f, ci = 0.f;
#pragma unroll
            for (int j = 0; j < 32; ++j) { const int k = 32 * w + j; const float er = END[pg8::end_lds_idx(k, p)], ei = END[pg8::end_lds_idx(k, 64 + p)];
                pr[j] = cr; pi[j] = ci; const float nr = ar * cr - ai * ci + er, ni = ar * ci + ai * cr + ei; cr = nr; ci = ni; }
            EX[(w * 2 + 0) * 64 + p] = cr; EX[(w * 2 + 1) * 64 + p] = ci;
            float qr = ar, qi = ai;
#pragma unroll
            for (int i = 0; i < 5; ++i) { const float nr = qr * qr - qi * qi, ni = 2.f * qr * qi; qr = nr; qi = ni; }
            LDS_WAIT(); __syncthreads();
            float sr = 0.f, si = 0.f;
            for (int v = 0; v < w; ++v) { const float er = EX[(v * 2 + 0) * 64 + p], ei = EX[(v * 2 + 1) * 64 + p]; const float nr = qr * sr - qi * si + er, ni = qr * si + qi * sr + ei; sr = nr; si = ni; }
            bf16* A = (bf16*)(ws + WS_U) + ((size_t)bg * NCH + 32 * w) * ALD + 256;
            float zr = sr, zi = si;
#pragma unroll
            for (int j = 0; j < 32; ++j) { A[j * ALD + p] = (bf16)f2bf(pr[j] + zr); A[j * ALD + 64 + p] = (bf16)f2bf(pi[j] + zi);
                const float nr = ar * zr - ai * zi, ni = ar * zi + ai * zr; zr = nr; zi = ni; }
        }
        VM_WAIT(); LDS_WAIT(); __syncthreads();
        { pg8::Gemm g{(const bf16*)(ws + WS_U), (const bf16*)(ws + WS_KW), BATCH * NG * NCH, NG * 256, ALD, ALD, ALD};
          pg8::EpiY E{(bf16*)(ws + WS_G)};
          pg8::gemm_phase<pg8::EpiY, pg8::OneUnit, false, PG8_SP2>(F.lds + RING_OFF, g, S, E); }
    } }
}
__device__ __forceinline__ void phase_glu_t1(Frame& F, const Args& args) {
    unsigned char* ws = args.ws;
    pg8::Gemm g{(const bf16*)(ws + WS_G), (const bf16*)(ws + WS_GLUW), MTOK, SW, SW, SW, SW};
    pg8::StaticOrder S; S.init(MTOK, SW, F.G, (int)blockIdx.x);
    pg8::EpiGlu E{(const bf16*)(ws + WS_G), (const bf16*)(ws + WS_GS), (bf16*)(ws + WS_OAS), args.in[21]};
    pg8::gemm_phase<pg8::EpiGlu, pg8::StaticOrder, PG8_ALIGN, PG8_SP2>(F.lds + RING_OFF, g, S, E);
}
__device__ __forceinline__ void phase_merge(Frame& F, const Args& args) {
    unsigned char* ws = args.ws;
    pg8::Gemm g{(const bf16*)(ws + WS_OAS), (const bf16*)(ws + WS_PAS), MTOK, DM, DM, DM, DM};
    pg8::StaticOrder S; S.init(MTOK, DM, F.G, (int)blockIdx.x);
    pg8::EpiMerge E{(const bf16*)(ws + WS_MG), (bf16*)(ws + WS_MRG)};
    pg8::gemm_phase<pg8::EpiMerge, pg8::StaticOrder, ALIGN_P5, PG8_SP2, 512>(F.lds + RING_OFF, g, S, E);
}
__device__ __forceinline__ void phase_out(Frame& F, const Args& args) {
    unsigned char* ws = args.ws;
    pg8::Gemm g{(const bf16*)(ws + WS_MRG), (const bf16*)(ws + WS_WOUT), MTOK, DM, DM, DM, DM};
    pg8::StaticOrder S; S.init(MTOK, DM, F.G, (int)blockIdx.x);
    pg8::EpiOut E{args.in[0], args.out};
    pg8::gemm_phase<pg8::EpiOut, pg8::StaticOrder, ALIGN_P6, PG8_SP2>(F.lds + RING_OFF, g, S, E);
}
#if USE_NAIVE
struct NArgs { const float* in[25]; float* out; unsigned char* ws; };
__device__ __forceinline__ void st_bf(bf16* p, size_t i, float v) { p[i] = (bf16)f2bf(v); }

template <int MODE> __global__ void __launch_bounds__(256) nk_gemm(NArgs a) {
    __shared__ float As[16][65], Bs[16][65], red[64][17];
    unsigned char* ws = a.ws; const float* tab = (const float*)(ws + WS_TAB);
    const bf16* A; const bf16* Bt; int K, lda;
    if (MODE == 1) { A = (const bf16*)(ws + WS_XN); Bt = (const bf16*)(ws + WS_WIN); K = 1024; lda = 1024; }
    else if (MODE == 3) { A = (const bf16*)(ws + WS_G); Bt = (const bf16*)(ws + WS_GLUW); K = 512; lda = 512; }
    else if (MODE == 4) { A = (const bf16*)(ws + WS_OA); Bt = (const bf16*)(ws + WS_PA); K = 512; lda = 512; }
    else if (MODE == 5) { A = (const bf16*)(ws + WS_OS); Bt = (const bf16*)(ws + WS_PS); K = 512; lda = 512; }
    else { A = (const bf16*)(ws + WS_T1); Bt = (const bf16*)(ws + WS_WOUT); K = 1024; lda = 1024; }
    const int tid = threadIdx.x, ty = tid >> 4, tx = tid & 15, m0 = blockIdx.y * 64, n0 = blockIdx.x * 64;
    float acc[4][4] = {};
    for (int k0 = 0; k0 < K; k0 += 16) {
        for (int i = tid; i < 1024; i += 256) { const int r = i >> 4, kk = i & 15;
            As[kk][r] = bf2f(A[(size_t)(m0 + r) * lda + k0 + kk]);
            const int n = n0 + r; const int br = (MODE == 1) ? rowmap_in(n) : n;
            Bs[kk][r] = bf2f(Bt[(size_t)br * K + k0 + kk]); }
        __syncthreads();
#pragma unroll
        for (int kk = 0; kk < 16; ++kk) { float av[4], bv[4];
#pragma unroll
            for (int i = 0; i < 4; ++i) { av[i] = As[kk][ty * 4 + i]; bv[i] = Bs[kk][tx * 4 + i]; }
#pragma unroll
            for (int i = 0; i < 4; ++i)
#pragma unroll
                for (int j = 0; j < 4; ++j) acc[i][j] += av[i] * bv[j]; }
        __syncthreads();
    }
    if (MODE == 1) {
        const int typ = n0 < 512 ? 0 : n0 < 1024 ? 1 : n0 < 1536 ? 2 : n0 < 2048 ? 3 : n0 < 2560 ? 4 : n0 < 3072 ? 5 : 6;
        float rstd[4] = {1.f, 1.f, 1.f, 1.f};
        if (typ <= 1) {
            for (int i = 0; i < 4; ++i) { float s = 0.f; for (int j = 0; j < 4; ++j) s += acc[i][j] * acc[i][j]; red[ty * 4 + i][tx] = s; }
            __syncthreads();
            for (int i = 0; i < 4; ++i) { float s = 0.f; for (int j = 0; j < 16; ++j) s += red[ty * 4 + i][j]; rstd[i] = rsqrtf(s * (1.0f / 64.0f) + 1e-6f); }
        }
        for (int i = 0; i < 4; ++i) { const int row = m0 + ty * 4 + i, b = row >> 12, t = row & 4095;
            for (int j = 0; j < 4; ++j) { const int n = n0 + tx * 4 + j; const float v = acc[i][j];
                if (typ == 0) { const int sh = n >> 6, d = n & 63; st_bf((bf16*)(ws + WS_Q), qk_index(b, sh >> 1, sh & 1, t, d), v * rstd[i] * tab[TB_QG + d]); }
                else if (typ == 1) { const int sh = (n - 512) >> 6, d = n & 63; st_bf((bf16*)(ws + WS_K), qk_index(b, sh >> 1, sh & 1, t, d), v * rstd[i] * tab[TB_KG + d]); }
                else if (typ == 2) { const int c = n - 1024; st_bf((bf16*)(ws + WS_V), v_index(b, c >> 7, t, c & 127), v); }
                else if (typ == 3) { st_bf((bf16*)(ws + WS_GA), (size_t)row * 512 + (n - 1536), siluf_(v)); }
                else if (typ == 4) { const int c = n - 2048; st_bf((bf16*)(ws + WS_U), u_index(b, c >> 4, t, c & 15), v); }
                else if (typ == 5) { st_bf((bf16*)(ws + WS_GS), (size_t)row * 512 + (n - 2560), siluf_(v)); }
                else { const int c = n - 3072; st_bf((bf16*)(ws + WS_MG), (size_t)row * 2048 + c, sigmoidf_(v + a.in[3][c])); } } }
    } else {
        for (int i = 0; i < 4; ++i) { const int row = m0 + ty * 4 + i;
            for (int j = 0; j < 4; ++j) { const int n = n0 + tx * 4 + j; const float v = acc[i][j];
                if (MODE == 3) { const float g = bf2f(((const bf16*)(ws + WS_G))[(size_t)row * 512 + n]); const float gs = bf2f(((const bf16*)(ws + WS_GS))[(size_t)row * 512 + n]);
                    st_bf((bf16*)(ws + WS_OS), (size_t)row * 512 + n, g * sigmoidf_(v + a.in[21][n]) * gs); }
                else if (MODE == 4) { const float ga = bf2f(((const bf16*)(ws + WS_MG))[(size_t)row * 2048 + n]); st_bf((bf16*)(ws + WS_T1), (size_t)row * 1024 + n, ga * v); }
                else if (MODE == 5) { const float gs = bf2f(((const bf16*)(ws + WS_MG))[(size_t)row * 2048 + 1024 + n]); bf16* T1 = (bf16*)(ws + WS_T1); const size_t ix = (size_t)row * 1024 + n; st_bf(T1, ix, bf2f(T1[ix]) + gs * v); }
                else { const size_t ix = (size_t)row * 1024 + n; a.out[ix] = a.in[0][ix] + v; } } }
    }
}

__global__ void __launch_bounds__(256) nk_attn(NArgs a) {
    __shared__ float Qs[2][16][64], Ps[2][16][65];
    unsigned char* ws = a.ws; const float* tab = (const float*)(ws + WS_TAB);
    const bf16* Q = (const bf16*)(ws + WS_Q); const bf16* Kb = (const bf16*)(ws + WS_K); const bf16* V = (const bf16*)(ws + WS_V);
    const int tid = threadIdx.x, ql = tid >> 4, part = tid & 15, q0 = blockIdx.x * 16, h = blockIdx.y, b = blockIdx.z;
    const float m0 = tab[TB_M0], lam = tab[TB_LAM];
    for (int i = tid; i < 2048; i += 256) { const int s = i >> 10, q = (i >> 6) & 15, d = i & 63; Qs[s][q][d] = bf2f(Q[qk_index(b, h, s, q0 + q, d)]); }
    __syncthreads();
    const int ntile = (q0 >> 6) + 1;
    float o[2][8] = {}; float lacc[2] = {0.f, 0.f};
    for (int kt = 0; kt < ntile; ++kt) {
        for (int i = tid; i < 2048; i += 256) { const int s = i >> 10, q = (i >> 6) & 15, k = i & 63, key = kt * 64 + k;
            float dot = 0.f; for (int d = 0; d < 64; ++d) dot += Qs[s][q][d] * bf2f(Kb[qk_index(b, h, s, key, d)]);
            const float bias = (a.in[11][rel_bucket(key - (q0 + q)) * 4 + h] - m0) * LOG2E;
            Ps[s][q][k] = exp2f(dot + bias); }
        __syncthreads();
        for (int s = 0; s < 2; ++s) {
            for (int k = part * 4; k < part * 4 + 4; ++k) lacc[s] += Ps[s][ql][k];
            for (int k = 0; k < 64; ++k) { const float p = Ps[s][ql][k]; const bf16* vr = V + v_index(b, h, kt * 64 + k, part * 8);
                for (int j = 0; j < 8; ++j) o[s][j] += p * bf2f(vr[j]); } }
        __syncthreads();
    }
    for (int s = 0; s < 2; ++s) for (int off = 1; off < 16; off <<= 1) lacc[s] += __shfl_xor(lacc[s], off);
    float ov[8], ss = 0.f;
    for (int j = 0; j < 8; ++j) { ov[j] = o[0][j] / lacc[0] - lam * o[1][j] / lacc[1]; ss += ov[j] * ov[j]; }
    for (int off = 1; off < 16; off <<= 1) ss += __shfl_xor(ss, off);
    const float rstd = rsqrtf(ss * (1.0f / 128.0f) + 1e-6f);
    const size_t row = (size_t)b * SEQ + q0 + ql;
    for (int j = 0; j < 8; ++j) { const int dv = part * 8 + j; const float ga = bf2f(((const bf16*)(ws + WS_GA))[row * 512 + h * 128 + dv]);
        st_bf((bf16*)(ws + WS_OA), row * 512 + h * 128 + dv, ov[j] * rstd * a.in[10][dv] * (1.0f - LAM_INIT) * ga); }
}

__global__ void __launch_bounds__(64) nk_ssm(NArgs a) {
    __shared__ float X[64][129], Us[64][16], cre[16][64], cim[16][64], bbr[64][17], bbi[64][17];
    unsigned char* ws = a.ws; const bf16* U = (const bf16*)(ws + WS_U); bf16* G = (bf16*)(ws + WS_G);
    const int p = threadIdx.x, bg = blockIdx.x, b = bg >> 5, g = bg & 31;
    const SsmConst sc = ssm_const(a.in[12], a.in[13], a.in[14], g, p);
    for (int h = 0; h < 16; ++h) { const double br = a.in[15][(g * SP + p) * 16 + h], bi = a.in[16][(g * SP + p) * 16 + h]; bbr[p][h] = (float)(sc.qr * br - sc.qi * bi); bbi[p][h] = (float)(sc.qr * bi + sc.qi * br); }
    for (int i = p; i < 1024; i += 64) { cre[i >> 6][i & 63] = a.in[17][g * 1024 + i]; cim[i >> 6][i & 63] = a.in[18][g * 1024 + i]; }
    const float lbr = (float)sc.lbr, lbi = (float)sc.lbi; float xr = 0.f, xi = 0.f;
    for (int c0 = 0; c0 < SEQ; c0 += 64) {
        __syncthreads();
        for (int i = p; i < 1024; i += 64) Us[i >> 4][i & 15] = bf2f(U[u_index(b, g, c0 + (i >> 4), i & 15)]);
        __syncthreads();
#pragma unroll 1
        for (int tt = 0; tt < 64; ++tt) { float br = 0.f, bi = 0.f;
#pragma unroll 4
            for (int h = 0; h < 16; ++h) { br += bbr[p][h] * Us[tt][h]; bi += bbi[p][h] * Us[tt][h]; }
            const float nr = lbr * xr - lbi * xi + br, ni = lbr * xi + lbi * xr + bi; xr = nr; xi = ni; X[tt][p] = xr; X[tt][64 + p] = xi; }
        __syncthreads();
#pragma unroll 1
        for (int h = 0; h < 16; ++h) { float y = a.in[19][g * 16 + h] * Us[p][h];
#pragma unroll 4
            for (int pp = 0; pp < 64; ++pp) y += cre[h][pp] * X[p][pp] - cim[h][pp] * X[p][64 + pp];
            st_bf(G, ((size_t)b * SEQ + c0 + p) * 512 + g * 16 + h, gelu_tanh(y)); }
    }
}
#endif
__global__ void __launch_bounds__(NWAVES * 64, 2) mega_fwd(Args args) {
    extern __shared__ __attribute__((aligned(16))) unsigned char lds[];
    Frame F;
    F.lds = (LAS unsigned char*)lds;
    F.MISC = (volatile LAS unsigned*)(F.lds + MISC_OFF);
    F.tid = threadIdx.x; F.lane = F.tid & 63; F.wave = __builtin_amdgcn_readfirstlane(F.tid >> 6);
    F.G = gridDim.x; { const int bx = blockIdx.x; F.vcu = (F.G % 8 == 0) ? (bx % 8) * (F.G / 8) + bx / 8 : bx; }
    unsigned char* ws = args.ws;
    F.ctl = (gu32*)(ws + WS_CTL);
    for (int u = F.tid; u < (LDS_BYTES - LDSCTL_OFF) / 4; u += NWAVES * 64) ((LAS unsigned*)(F.lds + LDSCTL_OFF))[u] = 0u;
    __syncthreads();
    const int lo = args.ph_lo, hi = args.ph_hi;
    XcdBarrier bar; bar.bar = (unsigned*)(F.ctl + CW_BAR) + args.li * XCD_BAR_WORDS; bar.x = 0; bar.st = nullptr;
    if (hi - lo > 1) bar = xcd_barrier_post((unsigned*)(F.ctl + CW_BAR) + args.li * XCD_BAR_WORDS, F.MISC + 8);
#define IN(k) (lo <= (k) && (k) < hi)
#ifdef PROBE_TS
    unsigned long long ts_[10]; int nts_ = 0;
#define STAMP() do { ts_[nts_++] = __builtin_amdgcn_s_memrealtime(); } while (0)
#else
#define STAMP() do {} while (0)
#endif
    STAMP();
#define BOTH(k) (IN(k) && IN((k) + 1))
#ifndef REP_MASK
#define REP_MASK 0
#endif
#ifndef GRP_BARRIERS
#define GRP_BARRIERS 1
#endif
#ifndef ALT_ORDER
#define ALT_ORDER 1
#endif
#ifndef ORDER_P
#define ORDER_P(g) (((g) & 1) ? 0 : 4)
#endif
#define NREP(k) (((REP_MASK >> (k)) & 1) ? 2 : 1)
#ifdef PROBE_P0B
    const unsigned long long tp0_ = __builtin_amdgcn_s_memrealtime();
    p0_prologue(F, args);
    const unsigned long long tp1_ = __builtin_amdgcn_s_memrealtime();
    xcd_barrier(bar);
    const unsigned long long tp2_ = __builtin_amdgcn_s_memrealtime();
#else
    if (IN(0)) for (int r_ = 0; r_ < NREP(0); ++r_) { p0_prologue(F, args); if (BOTH(0)) xcd_barrier(bar); }
#endif
    STAMP();
#if FAST_P1
    const bool grp = GRP_BARRIERS && F.G == 256 && lo == 0 && hi == 7; const int gb = F.vcu >> 5;
    XcdBarrier gbar = bar;
    if (grp) { gbar = xcd_barrier_post((unsigned*)(F.ctl + CW_GBAR) + gb * XCD_BAR_WORDS, F.MISC + 10); gbar.nmemb = 32u; }
#define SEAM(k) do { if (grp) xcd_barrier(gbar); else xcd_barrier(bar); } while (0)
    if (IN(1)) for (int r_ = 0; r_ < NREP(1); ++r_) { phase_inproj(F, args); if (BOTH(1)) SEAM(0); }
    STAMP();
#endif
#if ALT_ORDER
    {
        const int pcut = grp ? ORDER_P(gb) : 4;
        phase_attn(F, args, (char*)lds, 0, pcut);
        phase_ssm(F, args); SEAM(1); phase_glu_t1(F, args);
        phase_attn(F, args, (char*)lds, pcut, 4);
        SEAM(2);
    }
#else
#if FAST_ATT
    if (IN(2)) for (int r_ = 0; r_ < NREP(2); ++r_) { phase_attn(F, args, (char*)lds); }
    STAMP();
#endif
#if FAST_SSM
#ifdef PROBE_SSM
    const unsigned long long tss0_ = __builtin_amdgcn_s_memrealtime();
    if (IN(3)) { phase_ssm(F, args); }
    const unsigned long long tss1_ = __builtin_amdgcn_s_memrealtime();
    if (BOTH(3)) xcd_barrier(bar);
    const unsigned long long tss2_ = __builtin_amdgcn_s_memrealtime();
#else
    if (IN(3)) for (int r_ = 0; r_ < NREP(3); ++r_) { phase_ssm(F, args); if (BOTH(3)) SEAM(1); }
#endif
    STAMP();
#endif
#if FAST_P4
    if (IN(4)) for (int r_ = 0; r_ < NREP(4); ++r_) { phase_glu_t1(F, args); if (BOTH(4)) SEAM(2); }
    STAMP();
#endif
#endif
#if FAST_P5
    if (IN(5)) { phase_merge(F, args); if (BOTH(5)) SEAM(3); }
    STAMP();
#endif
#if FAST_P6
    if (IN(6)) for (int r_ = 0; r_ < NREP(6); ++r_) { phase_out(F, args); }
    STAMP();
#ifdef PROBE_TS
    xcd_barrier(bar); STAMP();
#endif
#ifdef PROBE_P0B
    if (blockIdx.x == PROBE_BLK) { const unsigned long long d_ = (PROBE_P0B == 1) ? (tp1_ - tp0_) : (tp2_ - tp1_), t0_ = __builtin_amdgcn_s_memrealtime(); while (__builtin_amdgcn_s_memrealtime() - t0_ < d_) __builtin_amdgcn_s_sleep(8); }
#endif
#ifdef PROBE_SSM
    if (blockIdx.x == 0) { const unsigned long long d_ = (PROBE_SSM == 1) ? (tss1_ - tss0_) : (tss2_ - tss1_), t0_ = __builtin_amdgcn_s_memrealtime(); while (__builtin_amdgcn_s_memrealtime() - t0_ < d_) __builtin_amdgcn_s_sleep(8); }
#endif
#ifdef PROBE_EPI
    if (blockIdx.x == 0) { __syncthreads(); const unsigned long long d_ = ((unsigned long long)F.MISC[27] << 32) | F.MISC[26], t0_ = __builtin_amdgcn_s_memrealtime(); while (__builtin_amdgcn_s_memrealtime() - t0_ < d_) __builtin_amdgcn_s_sleep(8); }
#endif
#ifdef PROBE_ATT
    if (blockIdx.x == 0) { __syncthreads(); const unsigned long long d_ = ((unsigned long long)F.MISC[25] << 32) | F.MISC[24], t0_ = __builtin_amdgcn_s_memrealtime(); while (__builtin_amdgcn_s_memrealtime() - t0_ < d_) __builtin_amdgcn_s_sleep(8); }
#endif
#ifdef PROBE_P0
    if (blockIdx.x == 0) { __syncthreads(); const unsigned long long a_ = ((unsigned long long)F.MISC[17 + 2 * PROBE_P0] << 32) | F.MISC[16 + 2 * PROBE_P0], b_ = ((unsigned long long)F.MISC[19 + 2 * PROBE_P0] << 32) | F.MISC[18 + 2 * PROBE_P0];
        const unsigned long long d_ = b_ - a_, t0_ = __builtin_amdgcn_s_memrealtime(); while (__builtin_amdgcn_s_memrealtime() - t0_ < d_) __builtin_amdgcn_s_sleep(8); }
#endif
#ifdef PROBE_TS
    if (blockIdx.x == 0) { const unsigned long long d_ = ts_[PROBE_TS + 1] - ts_[PROBE_TS], t0_ = __builtin_amdgcn_s_memrealtime(); while (__builtin_amdgcn_s_memrealtime() - t0_ < d_) __builtin_amdgcn_s_sleep(8); }
#endif
#endif
#undef IN
#undef BOTH
}

extern "C" void kernel_launch(void* const* d_in, const int* in_sizes, int n_in, void* d_out, int out_size, void* d_ws, size_t ws_size, hipStream_t stream) {
    static int grid = 0;
    if (grid == 0) {
        if (n_in != 25 || in_sizes[0] != MTOK * DM || out_size != MTOK * DM || ws_size < WS_TOTAL) { fprintf(stderr, "kernel_launch: unexpected shapes/workspace (n_in %d, in0 %d, out %d, ws %zu)\n", n_in, n_in > 0 ? in_sizes[0] : -1, out_size, ws_size); grid = -1; return; }
        int dev = 0, cus = 0, per_cu = 0;
        if (hipGetDevice(&dev) != hipSuccess || hipDeviceGetAttribute(&cus, hipDeviceAttributeMultiprocessorCount, dev) != hipSuccess) { grid = -1; return; }
        if (hipFuncSetAttribute((const void*)mega_fwd, hipFuncAttributeMaxDynamicSharedMemorySize, LDS_BYTES) != hipSuccess) { fprintf(stderr, "kernel_launch: hipFuncSetAttribute failed\n"); grid = -1; return; }
        if (hipOccupancyMaxActiveBlocksPerMultiprocessor(&per_cu, (const void*)mega_fwd, NWAVES * 64, LDS_BYTES) != hipSuccess || per_cu < 1) fprintf(stderr, "kernel_launch: occupancy query reports %d\n", per_cu);
        (void)hipGetLastError();
        grid = cus;
    }
    if (grid < 0) return;
    if (hipMemsetAsync((char*)d_ws + WS_CTL, 0, CTL_ZERO_BYTES, stream) != hipSuccess) return;
    Args a{};
    for (int i = 0; i < 25; ++i) a.in[i] = (const float*)d_in[i];
    a.out = (float*)d_out; a.ws = (unsigned char*)d_ws;
#if USE_NAIVE
    NArgs na{}; for (int i = 0; i < 25; ++i) na.in[i] = (const float*)d_in[i]; na.out = (float*)d_out; na.ws = (unsigned char*)d_ws;
#define MEGA(lo_, hi_) do { a.ph_lo = (lo_); a.ph_hi = (hi_); hipLaunchKernelGGL(mega_fwd, dim3(grid), dim3(NWAVES * 64), LDS_BYTES, stream, a); } while (0)
    MEGA(0, 1);
#ifdef DBG_POISON_P1
    (void)hipMemsetAsync((char*)d_ws + WS_Q, 0xFF, 64 * MiB + 32 * MiB + 32 * MiB, stream);
    (void)hipMemsetAsync((char*)d_ws + WS_U, 0xFF, 48 * MiB + 32 * MiB + 128 * MiB, stream);
#endif
#if FAST_P1
    MEGA(1, 2);
#else
    hipLaunchKernelGGL(nk_gemm<1>, dim3(NCOL / 64, MTOK / 64), dim3(256), 0, stream, na);
#endif
#if FAST_ATT
    MEGA(2, 3);
#else
    hipLaunchKernelGGL(nk_attn, dim3(SEQ / 16, NH, BATCH), dim3(256), 0, stream, na);
#endif
#if FAST_SSM
    MEGA(3, 4);
#else
    hipLaunchKernelGGL(nk_ssm, dim3(BATCH * NG), dim3(64), 0, stream, na);
#endif
#if FAST_P4
    MEGA(4, 5);
#else
    hipLaunchKernelGGL(nk_gemm<3>, dim3(512 / 64, MTOK / 64), dim3(256), 0, stream, na);
    hipLaunchKernelGGL(nk_gemm<4>, dim3(1024 / 64, MTOK / 64), dim3(256), 0, stream, na);
#endif
#if FAST_P5
    MEGA(5, 6);
#else
    hipLaunchKernelGGL(nk_gemm<5>, dim3(1024 / 64, MTOK / 64), dim3(256), 0, stream, na);
#endif
#if FAST_P6
    MEGA(6, 7);
#else
    hipLaunchKernelGGL(nk_gemm<6>, dim3(1024 / 64, MTOK / 64), dim3(256), 0, stream, na);
#endif
#undef MEGA
#else
#define MEGA(lo_, hi_) do { a.ph_lo = (lo_); a.ph_hi = (hi_); hipLaunchKernelGGL(mega_fwd, dim3(grid), dim3(NWAVES * 64), LDS_BYTES, stream, a); ++a.li; } while (0)
#if defined(PROBE_MODE) && PROBE_MODE == 1
    MEGA(0, 3); MEGA(3, 4); MEGA(3, 4); MEGA(4, 7);
#elif defined(PROBE_MODE) && PROBE_MODE == 2
    MEGA(0, 6); MEGA(4, 6); MEGA(6, 7);
#elif defined(PROBE_MODE) && PROBE_MODE == 3
    MEGA(0, 3); MEGA(3, 4); MEGA(4, 7);
#else
    MEGA(0, 7);
#endif
#undef MEGA
#endif
    const hipError_t le = hipPeekAtLastError();
    if (le != hipSuccess) fprintf(stderr, "kernel_launch: launch failed: %s\n", hipGetErrorName(le));
}
```
